# Optimizing an MI355X kernel written in HIP

```python
import math
import jax
import jax.numpy as jnp
from jax import lax
import numpy as np

D_MODEL = 2048
BATCH = 32
SEQ = 256
DEPTH = 2
DEC_BATCH = 2
DEC_SEQ = 4096
PAST_LEN = 512

GRID_W = 64
N_EVEN = (DEPTH + 1) // 2
N_ODD = DEPTH // 2
NORM_EPS = 1e-6

A_HEAD_DIM = 64
A_WIDTH = D_MODEL // 2
A_HEADS = A_WIDTH // A_HEAD_DIM
A_DECAY_RANK = 64
A_ICLR_RANK = 64
A_GATE_RANK = 128
A_COLS = 3 * A_WIDTH + 2 * A_DECAY_RANK + 2 * A_ICLR_RANK + A_GATE_RANK
A_GN_EPS = 64e-5

B_HEAD_DIM = 128
B_WIDTH = D_MODEL // 2
B_Q_HEADS = B_WIDTH // B_HEAD_DIM
B_KV_HEADS = B_Q_HEADS // 4
B_GROUP = B_Q_HEADS // B_KV_HEADS
B_KV_WIDTH = B_KV_HEADS * B_HEAD_DIM
B_COLS = B_WIDTH + 2 * B_KV_WIDTH
ROPE_THETA = 10000.0
Q_BLOCK = 128

C_WIDTH = D_MODEL
HYENA_ORDER = 2
FILT_EMB = 33
FILT_BANDS = (FILT_EMB - 1) // 2
FILT_HIDDEN = 64
DECAY_TARGET = 1e-2
FAST_DECAY_PCT = 0.3
SLOW_DECAY_PCT = 1.5

PEER_HEADS = 8
PEER_NKEYS = 128
PEER_EXPERTS = PEER_NKEYS * PEER_NKEYS
PEER_QDIM = 256
PEER_TOPK = 16
PEER_CHUNK = 128

kernel_name = "hybrid_diffusion_rwkv7_gqa_hyena_peer_step"

F32 = jnp.float32


def _rmsnorm(x, g):
    xf = x.astype(F32)
    y = xf * lax.rsqrt(jnp.mean(xf * xf, axis=-1, keepdims=True) + NORM_EPS)
    return y * g.astype(F32)


def _short_conv3(x, w):
    xp = jnp.pad(x, ((0, 0), (1, 1), (0, 0)))
    return xp[:, :-2] * w[0] + xp[:, 1:-1] * w[1] + xp[:, 2:] * w[2]


def _axial_rope(x):
    L = x.shape[1]
    n_rows = L // GRID_W
    row = jnp.repeat(jnp.arange(n_rows, dtype=F32), GRID_W)
    col = jnp.tile(jnp.arange(GRID_W, dtype=F32), n_rows)
    half = x.shape[-1] // 2
    nf = half // 2
    inv = ROPE_THETA ** (-jnp.arange(nf, dtype=F32) / nf)
    shape = (1, L) + (1,) * (x.ndim - 3) + (nf,)
    xf = x.astype(F32)

    def rot(xh, pos):
        ang = (pos[:, None] * inv[None, :]).reshape(shape)
        cs, sn = jnp.cos(ang), jnp.sin(ang)
        x1, x2 = xh[..., :nf], xh[..., nf:]
        return jnp.concatenate([x1 * cs - x2 * sn, x1 * sn + x2 * cs], axis=-1)

    return jnp.concatenate([rot(xf[..., :half], row), rot(xf[..., half:], col)], axis=-1)


def _attend(q, k, v):
    Bn, Lq, Hkv, G, Dh = q.shape
    nb = Lq // Q_BLOCK
    qb = jnp.moveaxis(q.astype(F32).reshape(Bn, nb, Q_BLOCK, Hkv, G, Dh), 1, 0)
    kf, vf = k.astype(F32), v.astype(F32)
    scale = Dh ** -0.5

    def one(qblk):
        s = jnp.einsum('bqhgd,bkhd->bhgqk', qblk, kf) * scale
        p = jax.nn.softmax(s, axis=-1)
        return jnp.einsum('bhgqk,bkhd->bqhgd', p, vf)

    o = lax.map(one, qb)
    return jnp.moveaxis(o, 0, 1).reshape(Bn, Lq, Hkv * G * Dh)


def _bidir_delta_scan(s0, r, w, kk, kt, a, v):
    def both(t):
        return jnp.stack([t, jnp.flip(t, 1)], axis=2)

    def rev1(t):
        return jnp.stack([t[:, :, 0], jnp.flip(t[:, :, 1], 1)], axis=2)

    xs = tuple(jnp.moveaxis(t.astype(F32), 1, 0)
               for t in (both(r), rev1(w), both(kk), rev1(kt), rev1(a), both(v)))

    def step(S, inp):
        r_t, w_t, kk_t, kt_t, a_t, v_t = inp
        sa = jnp.einsum('bdhvk,bdhk->bdhv', S, kk_t)
        S = (S * w_t[..., None, :] - sa[..., None] * (kk_t * a_t)[..., None, :]
             + v_t[..., None] * kt_t[..., None, :])
        return S, jnp.einsum('bdhvk,bdhk->bdhv', S, r_t)

    s_fin, ys = lax.scan(step, s0.astype(F32), xs)
    ys = jnp.moveaxis(ys, 0, 1)
    return ys[:, :, 0] + jnp.flip(ys[:, :, 1], 1), s_fin


def _rwkv7_mixer(za, s0, conv, w0, wu, a0, au, gu, k_k, k_a, r_k, ln_w, ln_b):
    Bn, L, _ = za.shape
    W, Rw, Ra = A_WIDTH, A_DECAY_RANK, A_ICLR_RANK
    za = _short_conv3(za.astype(F32), conv)
    r = za[..., :W]
    k = za[..., W:2 * W]
    v = za[..., 2 * W:3 * W]
    o = 3 * W
    wd = za[..., o:o + 2 * Rw].reshape(Bn, L, 2, Rw)
    o += 2 * Rw
    ad = za[..., o:o + 2 * Ra].reshape(Bn, L, 2, Ra)
    o += 2 * Ra
    gd = za[..., o:]
    w_log = -jax.nn.softplus(-(w0 + jnp.einsum('bldr,drc->bldc', jnp.tanh(wd), wu))) - 0.5
    w = jnp.exp(-jnp.exp(w_log))
    a = jax.nn.sigmoid(a0 + jnp.einsum('bldr,drc->bldc', ad, au))
    g = jax.nn.sigmoid(gd) @ gu
    hs = (Bn, L, A_HEADS, A_HEAD_DIM)
    dh = (Bn, L, 2, A_HEADS, A_HEAD_DIM)
    kk = (k * k_k).reshape(hs)
    kk = kk * lax.rsqrt(jnp.sum(kk * kk, axis=-1, keepdims=True) + 1e-12)
    kt = k[:, :, None, :] * (1.0 + (a - 1.0) * k_a)
    r_h, k_h, v_h = r.reshape(hs), k.reshape(hs), v.reshape(hs)
    y, s_fin = _bidir_delta_scan(s0, r_h, w.reshape(dh), kk, kt.reshape(dh), a.reshape(dh), v_h)
    mu = jnp.mean(y, axis=-1, keepdims=True)
    var = jnp.mean(jnp.square(y - mu), axis=-1, keepdims=True)
    yn = ((y - mu) * lax.rsqrt(var + A_GN_EPS)).reshape(Bn, L, W) * ln_w + ln_b
    bonus = (jnp.sum(r_h * k_h * r_k, axis=-1, keepdims=True) * v_h).reshape(Bn, L, W)
    return (yn + bonus) * g, s_fin


def _even_mixer(h, P, j, latent, cache_k, cache_v, state_a):
    Bn, L, _ = h.shape
    z = h @ P['even_w_in'][j]
    za, zb = z[..., :A_COLS], z[..., A_COLS:]
    q = _rmsnorm(zb[..., :B_WIDTH].reshape(Bn, L, B_KV_HEADS, B_GROUP, B_HEAD_DIM), P['even_b_qnorm'][j])
    k = _rmsnorm(zb[..., B_WIDTH:B_WIDTH + B_KV_WIDTH].reshape(Bn, L, B_KV_HEADS, B_HEAD_DIM), P['even_b_knorm'][j])
    v = zb[..., B_WIDTH + B_KV_WIDTH:].reshape(Bn, L, B_KV_HEADS, B_HEAD_DIM).astype(F32)
    if latent:
        q = _axial_rope(q)
        keys = jnp.concatenate([_axial_rope(k), cache_k[:, j].astype(F32)], axis=1)
        vals = jnp.concatenate([v, cache_v[:, j].astype(F32)], axis=1)
        s0 = state_a[:, j]
    else:
        keys, vals = k, v
        s0 = jnp.zeros((Bn, 2, A_HEADS, A_HEAD_DIM, A_HEAD_DIM), F32)
    y_b = _attend(q, keys, vals)
    y_a, s_fin = _rwkv7_mixer(za, s0, P['even_a_conv'][j], P['even_a_w0'][j], P['even_a_wu'][j],
                              P['even_a_a0'][j], P['even_a_au'][j], P['even_a_gu'][j], P['even_a_kk'][j],
                              P['even_a_ka'][j], P['even_a_rk'][j], P['even_a_ln_w'][j], P['even_a_ln_b'][j])
    y = jnp.concatenate([y_a, y_b], axis=-1) @ P['even_w_out'][j]
    return y, k, v, s_fin


def _hyena_filters(L, fw1, fb1, freq, fw2, fb2, fw3):
    t = jnp.linspace(0.0, 1.0, L, dtype=F32)[:, None]
    wpos = 2.0 * math.pi * jnp.arange(L, dtype=F32)[:, None] / L
    f = jnp.linspace(1e-4, FILT_BANDS - 1, FILT_BANDS, dtype=F32)[None, :]
    z = jnp.concatenate([t, jnp.cos(f * wpos), -jnp.sin(f * wpos)], axis=-1)
    fr = freq.astype(F32)
    hdn = jnp.sin(fr * (z @ fw1 + fb1))
    hdn = jnp.sin(fr * (hdn @ fw2 + fb2))
    filt = (hdn @ fw3).reshape(L, HYENA_ORDER, 2, C_WIDTH)
    deltas = jnp.abs(jnp.linspace(math.log(DECAY_TARGET) / SLOW_DECAY_PCT,
                                  math.log(DECAY_TARGET) / FAST_DECAY_PCT, C_WIDTH, dtype=F32))
    filt = filt * jnp.exp(-t * deltas[None, :])[:, None, None, :]
    return filt * lax.rsqrt(jnp.sum(filt * filt, axis=(0, 2), keepdims=True) + 1e-12)


def _bidir_long_conv(u, h_fwd, h_bwd):
    L = u.shape[1]
    f = jnp.concatenate([h_fwd, jnp.zeros((1, h_fwd.shape[1]), F32), jnp.flip(h_bwd[1:], 0)], axis=0)
    U = jnp.fft.rfft(u.astype(F32), n=2 * L, axis=1)
    Fh = jnp.fft.rfft(f, n=2 * L, axis=0)
    return jnp.fft.irfft(U * Fh[None], n=2 * L, axis=1)[:, :L]


def _hyena_mixer(h, w_in, conv, conv_b, fw1, fb1, freq, fw2, fb2, fw3, bias, w_out):
    L = h.shape[1]
    u = _short_conv3(h @ w_in, conv) + conv_b
    x1, x2, v = u[..., :C_WIDTH], u[..., C_WIDTH:2 * C_WIDTH], u[..., 2 * C_WIDTH:]
    filt = _hyena_filters(L, fw1, fb1, freq, fw2, fb2, fw3)
    z = v
    for n, gate in enumerate((x1, x2)):
        z = gate * (_bidir_long_conv(z, filt[:, n, 0], filt[:, n, 1]) + bias[n] * z)
    return z @ w_out


def _peer(h, wq, sub_keys, u_tab, v_tab):
    Bn, L, D = h.shape
    T = Bn * L
    x = h.reshape(T, D)
    q = (x @ wq).astype(F32).reshape(T, PEER_HEADS, 2, PEER_QDIM // 2)
    s = jnp.einsum('thcd,hcnd->thcn', q, sub_keys.astype(F32))
    s1, i1 = lax.top_k(s[:, :, 0], PEER_TOPK)
    s2, i2 = lax.top_k(s[:, :, 1], PEER_TOPK)
    cand = (s1[..., :, None] + s2[..., None, :]).reshape(T, PEER_HEADS, PEER_TOPK * PEER_TOPK)
    top, ci = lax.top_k(cand, PEER_TOPK)
    e = (jnp.take_along_axis(i1, ci // PEER_TOPK, axis=-1) * PEER_NKEYS
         + jnp.take_along_axis(i2, ci % PEER_TOPK, axis=-1))
    gate = jax.nn.softmax(top, axis=-1)
    nc = T // PEER_CHUNK

    def chunk(args):
        xc, ec, gc = args
        u = jnp.take(u_tab, ec, axis=0)
        act = jax.nn.gelu(jnp.einsum('chkd,cd->chk', u, xc), approximate=False)
        vv = jnp.take(v_tab, ec, axis=0)
        return jnp.einsum('chk,chkd->cd', gc * act, vv)

    out = lax.map(chunk, (x.reshape(nc, PEER_CHUNK, D),
                          e.reshape(nc, PEER_CHUNK, PEER_HEADS, PEER_TOPK),
                          gate.reshape(nc, PEER_CHUNK, PEER_HEADS, PEER_TOPK)))
    return out.reshape(Bn, L, D)


def _trunk(x, cond, P, latent, cache_k, cache_v, state_a):
    new_k, new_v, new_s = [], [], []
    for layer in range(DEPTH):
        j = layer // 2
        m = jax.nn.silu(cond.astype(F32)) @ P['mod_w'][layer] + P['mod_b'][layer]
        if m.ndim == 2:
            m = m[:, None, :]
        sh1, sc1, gt1, sh2, sc2, gt2 = jnp.split(m, 6, axis=-1)
        hm = _rmsnorm(x, P['norm1'][layer]) * (1.0 + sc1) + sh1
        if layer % 2 == 0:
            mix, k_c, v_c, s_c = _even_mixer(hm, P, j, latent, cache_k, cache_v, state_a)
            if not latent:
                new_k.append(k_c)
                new_v.append(v_c)
                new_s.append(s_c)
        else:
            mix = _hyena_mixer(hm, P['odd_w_in'][j], P['odd_c_conv'][j], P['odd_c_conv_b'][j],
                               P['odd_c_fw1'][j], P['odd_c_fb1'][j], P['odd_c_freq'][j],
                               P['odd_c_fw2'][j], P['odd_c_fb2'][j], P['odd_c_fw3'][j],
                               P['odd_c_bias'][j], P['odd_w_out'][j])
        x = x + gt1 * mix
        hm = _rmsnorm(x, P['norm2'][layer]) * (1.0 + sc2) + sh2
        x = x + gt2 * _peer(hm, P['peer_wq'][layer], P['peer_keys'][layer], P['peer_u'][layer], P['peer_v'][layer])
    return x, new_k, new_v, new_s


def setup_inputs(seed: int = 0) -> dict:
    key = jax.random.key(seed)
    ks = iter(jax.random.split(key, 48))

    def nrm(shape, scale):
        return jax.random.normal(next(ks), shape, F32) * scale

    centre = jnp.array([0.0, 1.0, 0.0], F32)[:, None]
    D = D_MODEL
    return {
        'x_prompt': nrm((BATCH, SEQ, D), 1.0),
        'x_sample': nrm((DEC_BATCH, DEC_SEQ, D), 1.0),
        'cache_b_k': nrm((DEC_BATCH, N_EVEN, PAST_LEN, B_KV_HEADS, B_HEAD_DIM), 1.0),
        'cache_b_v': nrm((DEC_BATCH, N_EVEN, PAST_LEN, B_KV_HEADS, B_HEAD_DIM), 1.0),
        'state_a': nrm((DEC_BATCH, N_EVEN, 2, A_HEADS, A_HEAD_DIM, A_HEAD_DIM), 0.3),
        'c': nrm((DEC_BATCH, D), 1.0),
        'c_ctx': nrm((D,), 1.0),
        'mod_w': nrm((DEPTH, D, 6 * D), 0.5 * D ** -0.5),
        'mod_b': nrm((DEPTH, 6 * D), 0.02),
        'norm1': 1.0 + nrm((DEPTH, D), 0.02),
        'norm2': 1.0 + nrm((DEPTH, D), 0.02),
        'even_w_in': nrm((N_EVEN, D, A_COLS + B_COLS), D ** -0.5),
        'even_a_conv': nrm((N_EVEN, 3, A_COLS), 0.2) + centre,
        'even_a_w0': nrm((N_EVEN, 2, A_WIDTH), 1.0) - 2.0,
        'even_a_wu': nrm((N_EVEN, 2, A_DECAY_RANK, A_WIDTH), 0.1),
        'even_a_a0': nrm((N_EVEN, 2, A_WIDTH), 0.5),
        'even_a_au': nrm((N_EVEN, 2, A_ICLR_RANK, A_WIDTH), 0.1),
        'even_a_gu': nrm((N_EVEN, A_GATE_RANK, A_WIDTH), A_GATE_RANK ** -0.5),
        'even_a_kk': 1.0 + nrm((N_EVEN, A_WIDTH), 0.1),
        'even_a_ka': 1.0 + nrm((N_EVEN, A_WIDTH), 0.1),
        'even_a_rk': nrm((N_EVEN, A_HEADS, A_HEAD_DIM), 0.1),
        'even_a_ln_w': 1.0 + nrm((N_EVEN, A_WIDTH), 0.02),
        'even_a_ln_b': nrm((N_EVEN, A_WIDTH), 0.02),
        'even_b_qnorm': 1.0 + nrm((N_EVEN, B_HEAD_DIM), 0.02),
        'even_b_knorm': 1.0 + nrm((N_EVEN, B_HEAD_DIM), 0.02),
        'even_w_out': nrm((N_EVEN, A_WIDTH + B_WIDTH, D), (A_WIDTH + B_WIDTH) ** -0.5),
        'odd_w_in': nrm((N_ODD, D, 3 * C_WIDTH), D ** -0.5),
        'odd_c_conv': nrm((N_ODD, 3, 3 * C_WIDTH), 0.2) + centre,
        'odd_c_conv_b': nrm((N_ODD, 3 * C_WIDTH), 0.02),
        'odd_c_fw1': nrm((N_ODD, FILT_EMB, FILT_HIDDEN), FILT_EMB ** -0.5),
        'odd_c_fb1': nrm((N_ODD, FILT_HIDDEN), 0.1),
        'odd_c_freq': 1.0 + nrm((N_ODD, FILT_HIDDEN), 0.1),
        'odd_c_fw2': nrm((N_ODD, FILT_HIDDEN, FILT_HIDDEN), FILT_HIDDEN ** -0.5),
        'odd_c_fb2': nrm((N_ODD, FILT_HIDDEN), 0.1),
        'odd_c_fw3': nrm((N_ODD, FILT_HIDDEN, HYENA_ORDER * 2 * C_WIDTH), FILT_HIDDEN ** -0.5),
        'odd_c_bias': nrm((N_ODD, HYENA_ORDER, C_WIDTH), 0.5),
        'odd_w_out': nrm((N_ODD, C_WIDTH, D), C_WIDTH ** -0.5),
        'peer_wq': nrm((DEPTH, D, PEER_HEADS * PEER_QDIM), D ** -0.5),
        'peer_keys': nrm((DEPTH, PEER_HEADS, 2, PEER_NKEYS, PEER_QDIM // 2), (PEER_QDIM // 2) ** -0.5),
        'peer_u': nrm((DEPTH, PEER_EXPERTS, D), D ** -0.5),
        'peer_v': nrm((DEPTH, PEER_EXPERTS, D), PEER_HEADS ** -0.5),
    }


def reference(x_prompt, x_sample, cache_b_k, cache_b_v, state_a, c, c_ctx, mod_w, mod_b, norm1, norm2,
              even_w_in, even_a_conv, even_a_w0, even_a_wu, even_a_a0, even_a_au, even_a_gu, even_a_kk,
              even_a_ka, even_a_rk, even_a_ln_w, even_a_ln_b, even_b_qnorm, even_b_knorm, even_w_out,
              odd_w_in, odd_c_conv, odd_c_conv_b, odd_c_fw1, odd_c_fb1, odd_c_freq, odd_c_fw2, odd_c_fb2,
              odd_c_fw3, odd_c_bias, odd_w_out, peer_wq, peer_keys, peer_u, peer_v):
    P = {
        'mod_w': mod_w, 'mod_b': mod_b, 'norm1': norm1, 'norm2': norm2,
        'even_w_in': even_w_in, 'even_a_conv': even_a_conv, 'even_a_w0': even_a_w0, 'even_a_wu': even_a_wu,
        'even_a_a0': even_a_a0, 'even_a_au': even_a_au, 'even_a_gu': even_a_gu, 'even_a_kk': even_a_kk,
        'even_a_ka': even_a_ka, 'even_a_rk': even_a_rk, 'even_a_ln_w': even_a_ln_w, 'even_a_ln_b': even_a_ln_b,
        'even_b_qnorm': even_b_qnorm, 'even_b_knorm': even_b_knorm, 'even_w_out': even_w_out,
        'odd_w_in': odd_w_in, 'odd_c_conv': odd_c_conv, 'odd_c_conv_b': odd_c_conv_b, 'odd_c_fw1': odd_c_fw1,
        'odd_c_fb1': odd_c_fb1, 'odd_c_freq': odd_c_freq, 'odd_c_fw2': odd_c_fw2, 'odd_c_fb2': odd_c_fb2,
        'odd_c_fw3': odd_c_fw3, 'odd_c_bias': odd_c_bias, 'odd_w_out': odd_w_out,
        'peer_wq': peer_wq, 'peer_keys': peer_keys, 'peer_u': peer_u, 'peer_v': peer_v,
    }
    y_prompt, nk, nv, ns = _trunk(x_prompt, c_ctx, P, False, None, None, None)
    y_sample, _, _, _ = _trunk(x_sample, c, P, True, cache_b_k, cache_b_v, state_a)
    new_cache_b_k = jnp.stack(nk, axis=1)
    new_cache_b_v = jnp.stack(nv, axis=1)
    new_state_a = jnp.stack(ns, axis=1)
    return (y_prompt, y_sample, new_cache_b_k, new_cache_b_v, new_state_a)
```

```cpp
#include <hip/hip_runtime.h>
#include <hip/hip_cooperative_groups.h>
#include <stdint.h>
#include <stdio.h>
namespace cg = cooperative_groups;

#define DI __device__ __forceinline__
typedef unsigned short bf16_t;
using bf16x8 = __attribute__((ext_vector_type(8))) short;
using s16x4  = __attribute__((ext_vector_type(4))) short;
using f32x16 = __attribute__((ext_vector_type(16))) float;
using u32x4  = __attribute__((ext_vector_type(4))) unsigned;
using u32x2  = __attribute__((ext_vector_type(2))) unsigned;

constexpr int NTH = 512;
constexpr int T = 16384, TP = 8192, DM = 2048;
constexpr int ZC = 4992;
constexpr int SKV_S = 4608;

enum { IN_X_PROMPT = 0, IN_X_SAMPLE, IN_CACHE_K, IN_CACHE_V, IN_STATE_A, IN_C, IN_C_CTX, IN_MOD_W, IN_MOD_B, IN_NORM1, IN_NORM2,
       IN_EW_IN, IN_EA_CONV, IN_EA_W0, IN_EA_WU, IN_EA_A0, IN_EA_AU, IN_EA_GU, IN_EA_KK, IN_EA_KA, IN_EA_RK, IN_EA_LNW, IN_EA_LNB,
       IN_EB_QN, IN_EB_KN, IN_EW_OUT,
       IN_OW_IN, IN_OC_CONV, IN_OC_CONVB, IN_OC_FW1, IN_OC_FB1, IN_OC_FREQ, IN_OC_FW2, IN_OC_FB2, IN_OC_FW3, IN_OC_BIAS, IN_OW_OUT,
       IN_PEER_WQ, IN_PEER_KEYS, IN_PEER_U, IN_PEER_V, N_IN };

struct Params { const float* in[N_IN]; float* out; char* ws; };

constexpr size_t OUT_Y = 0, OUT_NK = 33554432, OUT_NV = 35651584, OUT_NS = 37748736;

constexpr size_t al256(size_t x) { return (x + 255) / 256 * 256; }
constexpr size_t WS_WT_IN0  = 0;
constexpr size_t WS_WT_OUT0 = WS_WT_IN0 + (size_t)ZC * 2048 * 2;
constexpr size_t WS_WT_IN1  = WS_WT_OUT0 + (size_t)2048 * 2048 * 2;
constexpr size_t WS_WT_OUT1 = WS_WT_IN1 + (size_t)6144 * 2048 * 2;
constexpr size_t WS_WT_Q    = WS_WT_OUT1 + (size_t)2048 * 2048 * 2;
constexpr size_t WS_KEYS    = WS_WT_Q + (size_t)2 * 2048 * 2048 * 2;
constexpr size_t WS_WU_T    = WS_KEYS + (size_t)2 * 2048 * 128 * 2;
constexpr size_t WS_AU_T    = WS_WU_T + 262144;
constexpr size_t WS_GU_T    = WS_AU_T + 262144;
constexpr size_t WS_MPART   = WS_GU_T + 262144;
constexpr size_t WS_MOD     = WS_MPART + (size_t)2 * 64 * 3 * 12288 * 4;
constexpr size_t WS_HDN2    = WS_MOD + (size_t)2 * 3 * 12288 * 4;
constexpr size_t WS_FW3T    = al256(WS_HDN2 + (size_t)4352 * 64 * 4);
constexpr size_t WS_HDN2B   = WS_FW3T + (size_t)8192 * 64 * 2;
constexpr size_t WS_BAR     = al256(WS_HDN2B + (size_t)4352 * 64 * 2);
constexpr size_t WS_HM      = al256(WS_BAR + 16384);
constexpr size_t WS_Z0      = WS_HM + (size_t)T * 2048 * 2;
constexpr size_t WS_QB      = WS_Z0 + (size_t)T * ZC * 2;
constexpr size_t WS_KBP     = WS_QB + (size_t)T * 1024 * 2;
constexpr size_t WS_VBP     = WS_KBP + (size_t)8192 * 256 * 2;
constexpr size_t WS_KBS     = WS_VBP + (size_t)8192 * 256 * 2;
constexpr size_t WS_VBS     = WS_KBS + (size_t)2 * SKV_S * 256 * 2;
constexpr size_t WS_ACTA    = WS_VBS + (size_t)2 * SKV_S * 256 * 2;
constexpr size_t WS_BON     = WS_ACTA + (size_t)T * 384 * 2;
constexpr size_t WS_RW      = WS_BON + (size_t)T * 16 * 4;
constexpr size_t WS_R       = WS_RW;
constexpr size_t WS_KK      = WS_R + (size_t)T * 1024 * 4;
constexpr size_t WS_V       = WS_KK + (size_t)T * 1024 * 4;
constexpr size_t WS_W       = WS_V + (size_t)T * 1024 * 4;
constexpr size_t WS_KKA     = WS_W + (size_t)T * 2048 * 4;
constexpr size_t WS_KT      = WS_KKA + (size_t)T * 2048 * 4;
constexpr size_t WS_END     = WS_KT + (size_t)T * 2048 * 4;
constexpr size_t WS_G       = WS_Z0;
constexpr size_t WS_A2      = WS_Z0 + (size_t)T * 1024 * 4;
static_assert(WS_A2 + (size_t)T * 2048 * 2 <= WS_QB, "overlay");
constexpr size_t WS_UB      = WS_END;
constexpr size_t WS_END2    = WS_UB + (size_t)2 * 16384 * 2048;
constexpr size_t WS_VB      = WS_Z0 + (size_t)T * 1024 * 4 + (size_t)T * 2048 * 2;
static_assert(WS_VB + (size_t)2 * 16384 * 2048 <= WS_BON, "v tables overlay");
constexpr size_t WS_SC      = WS_RW;
constexpr size_t WS_UT      = WS_SC;
constexpr size_t WS_IDX     = WS_SC + (size_t)6144 * T * 2;
constexpr size_t WS_GATE    = WS_IDX + (size_t)T * 128 * 4;
constexpr size_t WS_FILT    = WS_GATE + (size_t)T * 128 * 4;
static_assert(WS_FILT + (size_t)8192 * 4352 * 2 <= WS_END, "overlay2");
constexpr size_t WS_TSC     = WS_MPART;
constexpr size_t WS_PQ      = WS_Z0;
constexpr size_t WS_Z2T     = WS_Z0;
static_assert(WS_END2 <= (size_t)1024 * 1024 * 1024, "ws budget");

constexpr int LDS_BYTES = 147456;

DI int tid_() { int t = __builtin_amdgcn_workitem_id_x(); asm volatile("" : "+v"(t)); return t; }
DI float bf2f(bf16_t b) { return __uint_as_float(((unsigned)b) << 16); }
DI unsigned pack2(float lo, float hi) { unsigned r; asm("v_cvt_pk_bf16_f32 %0, %1, %2" : "=v"(r) : "v"(lo), "v"(hi)); return r; }
DI bf16_t f2bf(float x) { return (bf16_t)(pack2(x, x) & 0xffffu); }
DI float lo2f(unsigned u) { return __uint_as_float(u << 16); }
DI float hi2f(unsigned u) { return __uint_as_float(u & 0xffff0000u); }
DI int crow(int r, int h) { return (r & 3) + 8 * (r >> 2) + 4 * h; }
template <int CTRL> DI float dppf(float x) { return __int_as_float(__builtin_amdgcn_update_dpp(0, __float_as_int(x), CTRL, 0xf, 0xf, false)); }
DI float rdlane(float v, int l) { return __int_as_float(__builtin_amdgcn_readlane(__float_as_int(v), l)); }
DI float wave_sum(float v) {
  v += dppf<0xB1>(v); v += dppf<0x4E>(v); v += dppf<0x141>(v); v += dppf<0x140>(v);
  return (rdlane(v, 0) + rdlane(v, 16)) + (rdlane(v, 32) + rdlane(v, 48));
}
DI float wave_max(float v) {
  v = fmaxf(v, dppf<0xB1>(v)); v = fmaxf(v, dppf<0x4E>(v)); v = fmaxf(v, dppf<0x141>(v)); v = fmaxf(v, dppf<0x140>(v));
  return fmaxf(fmaxf(rdlane(v, 0), rdlane(v, 16)), fmaxf(rdlane(v, 32), rdlane(v, 48)));
}
DI float sigmoidf_(float x) { return __builtin_amdgcn_rcpf(1.f + __expf(-x)); }
DI int cvec_of(int t) { return t < TP ? 0 : 1 + ((t - TP) >> 12); }
template <int LPR> DI float row_reduce(float x) {
  x += dppf<0xB1>(x);
  x += dppf<0x4E>(x);
  if (LPR == 8) { x += dppf<0x141>(x); }
  if (LPR == 16) { x += dppf<0x124>(x); x += dppf<0x128>(x); }
  return x;
}
DI void unpack8(u32x4 u, float* f) {
  f[0] = lo2f(u[0]); f[1] = hi2f(u[0]); f[2] = lo2f(u[1]); f[3] = hi2f(u[1]);
  f[4] = lo2f(u[2]); f[5] = hi2f(u[2]); f[6] = lo2f(u[3]); f[7] = hi2f(u[3]);
}

#define XB_TMO      128
#define XB_XCNT(j)  (256  + 64 * (j))
#define XB_XSUB(j)  (1280 + 64 * (j))
#define XB_XGEN(j)  (2304 + 64 * (j))
#define XB_TOP      3328
#define XB_TOPGEN   3392
#define XCD_BAR_WORDS 3456
#define XB_SPIN_CAP (1u << 18)
#define LAS __attribute__((address_space(3)))
DI unsigned xb_ld(unsigned* p)              { return __hip_atomic_load(p, __ATOMIC_RELAXED, __HIP_MEMORY_SCOPE_AGENT); }
DI unsigned xb_add(unsigned* p, unsigned v) { return __hip_atomic_fetch_add(p, v, __ATOMIC_RELAXED, __HIP_MEMORY_SCOPE_AGENT); }
DI unsigned xb_xcc_id() { return (unsigned)__builtin_amdgcn_s_getreg((3 << 11) | 20) & 0xFu; }
#define XB_SPIN(cond, bar) do { unsigned _sp = 0; while (cond) { __builtin_amdgcn_s_sleep(1); \
    if ((++_sp & 255u) == 0u) { if (xb_ld(&(bar)[XB_TMO])) break; if (_sp > XB_SPIN_CAP) { atomicAdd(&(bar)[XB_TMO], 1u); break; } } } } while (0)
struct XcdBarrier { unsigned* bar; unsigned x; volatile LAS unsigned* st; };
DI XcdBarrier xcd_barrier_post(unsigned* bar, volatile LAS unsigned* st) {
  XcdBarrier b; b.bar = bar; b.x = xb_xcc_id(); b.st = st;
  if (__builtin_amdgcn_workitem_id_x() == 0) (void)xb_add(&bar[XB_XCNT(b.x)], 1u);
  return b;
}
DI void xcd_barrier_complete(unsigned* bar, unsigned x, unsigned& nloc, unsigned& nx) {
  const unsigned G = gridDim.x * gridDim.y * gridDim.z;
  unsigned sum, cnt, mine, sp = 0u;
  for (;;) {
    sum = 0u; cnt = 0u; mine = 0u;
#pragma unroll
    for (unsigned j = 0; j < 16; ++j) { const unsigned c = xb_ld(&bar[XB_XCNT(j)]); sum += c; cnt += (c > 0u) ? 1u : 0u; mine = (j == x) ? c : mine; }
    if (sum == G) break;
    __builtin_amdgcn_s_sleep(1);
    if ((++sp & 255u) == 0u) { if (xb_ld(&bar[XB_TMO])) break; if (sp > XB_SPIN_CAP) { atomicAdd(&bar[XB_TMO], 1u); break; } }
  }
  nloc = mine > 0u ? mine : 1u; nx = cnt > 0u ? cnt : 1u;
}
DI void xcd_barrier(const XcdBarrier& b) {
  asm volatile("s_waitcnt vmcnt(0)" ::: "memory");
  __syncthreads();
  if (__builtin_amdgcn_workitem_id_x() == 0) {
    unsigned* bar = b.bar;
    __builtin_amdgcn_s_waitcnt(0);
    unsigned nloc = b.st[0], nx = b.st[1];
    if (nloc == 0u) { xcd_barrier_complete(bar, b.x, nloc, nx); b.st[0] = nloc; b.st[1] = nx; }
    const unsigned old = xb_add(&bar[XB_XSUB(b.x)], 1u);
    const unsigned gen = old / nloc;
    if (old + 1u == (gen + 1u) * nloc) {
      __builtin_amdgcn_fence(__ATOMIC_RELEASE, "agent");
      asm volatile("s_waitcnt vmcnt(0)" ::: "memory");
      const unsigned og = xb_add(&bar[XB_TOP], 1u);
      const unsigned tg = og / nx;
      if (og + 1u == (tg + 1u) * nx) xb_add(&bar[XB_TOPGEN], 1u);
      else XB_SPIN(xb_ld(&bar[XB_TOPGEN]) == tg, bar);
      __builtin_amdgcn_fence(__ATOMIC_ACQUIRE, "agent");
      xb_add(&bar[XB_XGEN(b.x)], 1u);
      asm volatile("s_waitcnt vmcnt(0)" ::: "memory");
    } else {
      XB_SPIN(xb_ld(&bar[XB_XGEN(b.x)]) == gen, bar);
      __builtin_amdgcn_fence(__ATOMIC_ACQUIRE, "agent");
      asm volatile("s_waitcnt vmcnt(0)" ::: "memory");
    }
  }
  __syncthreads();
}

DI void transpose_tiles(const float* __restrict__ W, bf16_t* __restrict__ Wt, int K, int N, float* lds) {
  const int tn = N / 64, ntile = (K / 64) * tn, tid = tid_();
  for (int tile = blockIdx.x; tile < ntile; tile += gridDim.x) {
    const int k0 = (tile / tn) * 64, n0 = (tile % tn) * 64;
    const int r = tid >> 4, c4 = tid & 15;
#pragma unroll
    for (int i = 0; i < 2; i++) {
      float4 v = *(const float4*)&W[(size_t)(k0 + r + 32 * i) * N + n0 + c4 * 4];
      float* d = &lds[(r + 32 * i) * 65 + c4 * 4]; d[0] = v.x; d[1] = v.y; d[2] = v.z; d[3] = v.w;
    }
    __syncthreads();
    const int n = tid >> 3, kc = tid & 7;
    u32x4 o;
#pragma unroll
    for (int j = 0; j < 4; j++) o[j] = pack2(lds[(kc * 8 + 2 * j) * 65 + n], lds[(kc * 8 + 2 * j + 1) * 65 + n]);
    *(u32x4*)&Wt[(size_t)(n0 + n) * K + k0 + kc * 8] = o;
    __syncthreads();
  }
}
DI void convert_bf16(const float* __restrict__ src, bf16_t* __restrict__ dst, size_t n8) {
  for (size_t i = (size_t)blockIdx.x * NTH + tid_(); i < n8; i += (size_t)gridDim.x * NTH) {
    float4 a = *(const float4*)&src[i * 8], b = *(const float4*)&src[i * 8 + 4];
    u32x4 o = {pack2(a.x, a.y), pack2(a.z, a.w), pack2(b.x, b.y), pack2(b.z, b.w)};
    *(u32x4*)&dst[i * 8] = o;
  }
}

DI void convert_fp8_rows(const float* __restrict__ src, unsigned char* __restrict__ dst, float* __restrict__ invs, int rows) {
  const int lane = tid_() & 63, wave = tid_() >> 6;
  for (int r = blockIdx.x * 8 + wave; r < rows; r += gridDim.x * 8) {
    const float* x = src + (size_t)r * 2048;
    float4 v[8]; float mx = 0.f;
#pragma unroll
    for (int hsel = 0; hsel < 2; hsel++)
#pragma unroll
      for (int i = 0; i < 4; i++) {
        v[hsel * 4 + i] = *(const float4*)&x[hsel * 1024 + lane * 16 + i * 4];
        const float4 a = v[hsel * 4 + i];
        mx = fmaxf(mx, fmaxf(fmaxf(fabsf(a.x), fabsf(a.y)), fmaxf(fabsf(a.z), fabsf(a.w))));
      }
    mx = fmaxf(wave_max(mx), 1e-30f);
    const float sc = 224.f / mx;
    if (lane == 0) invs[r] = mx * (1.f / 224.f);
#pragma unroll
    for (int hsel = 0; hsel < 2; hsel++) {
      u32x4 o;
#pragma unroll
      for (int i = 0; i < 4; i++) {
        const float4 a = v[hsel * 4 + i];
        int w = __builtin_amdgcn_cvt_pk_fp8_f32(a.x * sc, a.y * sc, 0, false);
        w = __builtin_amdgcn_cvt_pk_fp8_f32(a.z * sc, a.w * sc, w, true);
        o[i] = (unsigned)w;
      }
      *(u32x4*)&dst[(size_t)r * 2048 + hsel * 1024 + lane * 16] = o;
    }
  }
}
DI void convert_fp8_rows_w(const float* __restrict__ src, unsigned char* __restrict__ dst, float* __restrict__ invs, int rows, int widx, int nw) {
  const int lane = tid_() & 63;
  for (int r = widx; r < rows; r += nw) {
    const float* x = src + (size_t)r * 2048;
    float4 v[8]; float mx = 0.f;
#pragma unroll
    for (int hsel = 0; hsel < 2; hsel++)
#pragma unroll
      for (int i = 0; i < 4; i++) {
        v[hsel * 4 + i] = *(const float4*)&x[hsel * 1024 + lane * 16 + i * 4];
        const float4 a = v[hsel * 4 + i];
        mx = fmaxf(mx, fmaxf(fmaxf(fabsf(a.x), fabsf(a.y)), fmaxf(fabsf(a.z), fabsf(a.w))));
      }
    mx = fmaxf(wave_max(mx), 1e-30f);
    const float sc = 224.f / mx;
    if (lane == 0) invs[r] = mx * (1.f / 224.f);
#pragma unroll
    for (int hsel = 0; hsel < 2; hsel++) {
      u32x4 o;
#pragma unroll
      for (int i = 0; i < 4; i++) {
        const float4 a = v[hsel * 4 + i];
        int w = __builtin_amdgcn_cvt_pk_fp8_f32(a.x * sc, a.y * sc, 0, false);
        w = __builtin_amdgcn_cvt_pk_fp8_f32(a.z * sc, a.w * sc, w, true);
        o[i] = (unsigned)w;
      }
      *(u32x4*)&dst[(size_t)r * 2048 + hsel * 1024 + lane * 16] = o;
    }
  }
}
DI void transpose_tiles_w(const float* __restrict__ W, bf16_t* __restrict__ Wt, int K, int N, float* wl, int widx, int nw) {
  const int lane = tid_() & 63;
  const int tn = N / 64, ntile = (K / 64) * tn;
  for (int tile = widx; tile < ntile; tile += nw) {
    const int k0 = (tile / tn) * 64, n0 = (tile % tn) * 64;
    const int r = lane >> 4, c4 = lane & 15;
#pragma unroll
    for (int i = 0; i < 16; i++) {
      const float4 v = *(const float4*)&W[(size_t)(k0 + r + 4 * i) * N + n0 + c4 * 4];
      float* d = &wl[(r + 4 * i) * 65 + c4 * 4]; d[0] = v.x; d[1] = v.y; d[2] = v.z; d[3] = v.w;
    }
    asm volatile("s_waitcnt lgkmcnt(0)" ::: "memory");
#pragma unroll
    for (int kc = 0; kc < 8; kc++) {
      u32x4 o;
#pragma unroll
      for (int j = 0; j < 4; j++) o[j] = pack2(wl[(kc * 8 + 2 * j) * 65 + lane], wl[(kc * 8 + 2 * j + 1) * 65 + lane]);
      *(u32x4*)&Wt[(size_t)(n0 + lane) * K + k0 + kc * 8] = o;
    }
    asm volatile("s_waitcnt lgkmcnt(0)" ::: "memory");
  }
}
DI void unpack16_fp8(u32x4 u, float* f) {
#pragma unroll
  for (int i = 0; i < 4; i++) {
    const auto lo = __builtin_amdgcn_cvt_pk_f32_fp8((int)u[i], false), hi = __builtin_amdgcn_cvt_pk_f32_fp8((int)u[i], true);
    f[i * 4] = lo[0]; f[i * 4 + 1] = lo[1]; f[i * 4 + 2] = hi[0]; f[i * 4 + 3] = hi[1];
  }
}

DI void phase_mod_partial(const Params& p) {
  const float* mod_w = p.in[IN_MOD_W]; const float* c = p.in[IN_C]; const float* cctx = p.in[IN_C_CTX];
  float* mpart = (float*)(p.ws + WS_MPART);
  for (int it = blockIdx.x; it < 768; it += gridDim.x) {
    const int l = it / 384, rem = it % 384, kc = rem / 6, jb = rem % 6;
    const int j = jb * 2048 + tid_() * 4;
    float4 a0 = {0, 0, 0, 0}, a1 = a0, a2 = a0;
    for (int kk = 0; kk < 32; kk++) {
      const int k = kc * 32 + kk;
      const float4 w = *(const float4*)&mod_w[((size_t)l * 2048 + k) * 12288 + j];
      float x0 = cctx[k], x1 = c[k], x2 = c[2048 + k];
      float s0 = x0 * sigmoidf_(x0), s1 = x1 * sigmoidf_(x1), s2 = x2 * sigmoidf_(x2);
      a0.x += s0 * w.x; a0.y += s0 * w.y; a0.z += s0 * w.z; a0.w += s0 * w.w;
      a1.x += s1 * w.x; a1.y += s1 * w.y; a1.z += s1 * w.z; a1.w += s1 * w.w;
      a2.x += s2 * w.x; a2.y += s2 * w.y; a2.z += s2 * w.z; a2.w += s2 * w.w;
    }
    float* o = mpart + ((size_t)(l * 64 + kc) * 3) * 12288 + j;
    *(float4*)o = a0; *(float4*)(o + 12288) = a1; *(float4*)(o + 2 * 12288) = a2;
  }
}
DI void phase_mod_reduce(const Params& p) {
  const float* mpart = (const float*)(p.ws + WS_MPART); float* m = (float*)(p.ws + WS_MOD); const float* mod_b = p.in[IN_MOD_B];
  for (int i = blockIdx.x * NTH + tid_(); i < 2 * 3 * 12288; i += gridDim.x * NTH) {
    const int l = i / 36864, rem = i % 36864, cv = rem / 12288, j = rem % 12288;
    float s = mod_b[l * 12288 + j];
    for (int kc = 0; kc < 64; kc++) s += mpart[((size_t)(l * 64 + kc) * 3 + cv) * 12288 + j];
    m[i] = s;
  }
}

DI void phase_hdn2(const Params& p) {
  const float* fw1 = p.in[IN_OC_FW1]; const float* fb1 = p.in[IN_OC_FB1]; const float* fr = p.in[IN_OC_FREQ];
  const float* fw2 = p.in[IN_OC_FW2]; const float* fb2 = p.in[IN_OC_FB2];
  float* hdn2 = (float*)(p.ws + WS_HDN2);
  const int lane = tid_() & 63, wave = tid_() >> 6;
  for (int row = blockIdx.x * 8 + wave; row < 4352; row += gridDim.x * 8) {
    const int L = row < 256 ? 256 : 4096, i = row < 256 ? row : row - 256;
    const float tl = (float)i / (float)(L - 1);
    const float wpos = 6.283185307179586f * (float)i / (float)L;
    float acc = fb1[lane] + tl * fw1[lane];
    for (int b = 0; b < 16; b++) {
      const float f = 1e-4f + (float)b * ((15.f - 1e-4f) / 15.f);
      const float ang = f * wpos;
      acc += cosf(ang) * fw1[(1 + b) * 64 + lane];
      acc += -sinf(ang) * fw1[(17 + b) * 64 + lane];
    }
    const float h1 = sinf(fr[lane] * acc);
    float acc2 = fb2[lane];
    for (int k = 0; k < 64; k++) acc2 += __shfl(h1, k) * fw2[k * 64 + lane];
    const float h2 = sinf(fr[lane] * acc2);
    hdn2[row * 64 + lane] = h2; ((bf16_t*)(p.ws + WS_HDN2B))[row * 64 + lane] = f2bf(h2);
  }
}

DI void phase_norm(const float* __restrict__ x0, const float* __restrict__ x1, const float* __restrict__ gamma,
                   const float* __restrict__ mod, int sh_off, int sc_off, bf16_t* __restrict__ hm) {
  const int lane = tid_() & 63, wave = tid_() >> 6;
  for (int t = blockIdx.x * 8 + wave; t < T; t += gridDim.x * 8) {
    const float* x = t < TP ? x0 + (size_t)t * 2048 : x1 + (size_t)(t - TP) * 2048;
    const float* m = mod + cvec_of(t) * 12288;
    float4 v[8]; float ss = 0;
#pragma unroll
    for (int i = 0; i < 8; i++) { v[i] = ((const float4*)x)[i * 64 + lane]; ss += v[i].x * v[i].x + v[i].y * v[i].y + v[i].z * v[i].z + v[i].w * v[i].w; }
    ss = wave_sum(ss);
    const float rstd = rsqrtf(ss * (1.f / 2048.f) + 1e-6f);
#pragma unroll
    for (int i = 0; i < 8; i++) {
      const int n = (i * 64 + lane) * 4;
      const float4 g = *(const float4*)&gamma[n], sc = *(const float4*)&m[sc_off + n], sh = *(const float4*)&m[sh_off + n];
      float a = v[i].x * rstd * g.x * (1.f + sc.x) + sh.x, b = v[i].y * rstd * g.y * (1.f + sc.y) + sh.y;
      float c = v[i].z * rstd * g.z * (1.f + sc.z) + sh.z, d = v[i].w * rstd * g.w * (1.f + sc.w) + sh.w;
      u32x2 o = {pack2(a, b), pack2(c, d)};
      *(u32x2*)&hm[(size_t)t * 2048 + n] = o;
    }
  }
}

template <int BN, class Epi>
DI void gemm_tile(const bf16_t* __restrict__ A, int lda, const bf16_t* __restrict__ Bt, int ldb, int m0, int n0, int N, int K, const Epi& epi, char* lds) {
  constexpr int WN = BN / 4, NJ = WN / 32, NB = BN / 64;
  constexpr int ROWB = 144;
  constexpr int STAGE = (256 + BN) * ROWB;
  const int tid = tid_(), wave = tid >> 6, lane = tid & 63, r32 = lane & 31, h = lane >> 5;
  const int wm = wave >> 2, wn = wave & 3;
  f32x16 acc[4][NJ];
#pragma unroll
  for (int i = 0; i < 4; i++)
#pragma unroll
    for (int j = 0; j < NJ; j++)
#pragma unroll
      for (int r = 0; r < 16; r++) acc[i][j][r] = 0.f;
  u32x4 ra[4], rb[NB];
  const int srow = tid >> 3, sc = tid & 7;
  const bf16_t* Ap = A + (size_t)(m0 + srow) * lda + sc * 8;
  const bf16_t* Bp[NB];
#pragma unroll
  for (int i = 0; i < NB; i++) { int n = n0 + srow + 64 * i; n = n < N ? n : N - 1; Bp[i] = Bt + (size_t)n * ldb + sc * 8; }
  auto gload = [&](int k0) {
#pragma unroll
    for (int i = 0; i < 4; i++) ra[i] = *(const u32x4*)(Ap + (size_t)(64 * i) * lda + k0);
#pragma unroll
    for (int i = 0; i < NB; i++) rb[i] = *(const u32x4*)(Bp[i] + k0);
  };
  auto swrite = [&](int st) {
    char* As = lds + st * STAGE; char* Bs = As + 256 * ROWB;
#pragma unroll
    for (int i = 0; i < 4; i++) *(u32x4*)(As + (srow + 64 * i) * ROWB + sc * 16) = ra[i];
#pragma unroll
    for (int i = 0; i < NB; i++) *(u32x4*)(Bs + (srow + 64 * i) * ROWB + sc * 16) = rb[i];
  };
  auto compute = [&](int st, int ks) {
    const char* As = lds + st * STAGE; const char* Bs = As + 256 * ROWB;
    bf16x8 af[4], bfr[NJ];
#pragma unroll
    for (int i = 0; i < 4; i++) af[i] = *(const bf16x8*)(As + (wm * 128 + i * 32 + r32) * ROWB + (ks * 16 + h * 8) * 2);
#pragma unroll
    for (int j = 0; j < NJ; j++) bfr[j] = *(const bf16x8*)(Bs + (wn * WN + j * 32 + r32) * ROWB + (ks * 16 + h * 8) * 2);
#pragma unroll
    for (int i = 0; i < 4; i++)
#pragma unroll
      for (int j = 0; j < NJ; j++) acc[i][j] = __builtin_amdgcn_mfma_f32_32x32x16_bf16(af[i], bfr[j], acc[i][j], 0, 0, 0);
  };
  const int KT = K / 64;
  __syncthreads();
  gload(0); swrite(0);
  if (KT > 1) gload(64);
  __syncthreads();
  for (int kt = 0; kt < KT; kt++) {
    const int st = kt & 1;
    compute(st, 0); compute(st, 1);
    if (kt + 1 < KT) { swrite(st ^ 1); if (kt + 2 < KT) gload((kt + 2) * 64); }
    compute(st, 2); compute(st, 3);
    __syncthreads();
  }
#pragma unroll
  for (int i = 0; i < 4; i++)
#pragma unroll
    for (int j = 0; j < NJ; j++) {
      const int n = n0 + wn * WN + j * 32 + r32;
      __builtin_amdgcn_sched_barrier(0);
      if (n < N) {
#pragma unroll
        for (int r = 0; r < 16; r++) {
          epi(m0 + wm * 128 + i * 32 + crow(r, h), n, acc[i][j][r]);
          if ((r + 1) % Epi::GROUP == 0) asm volatile("" ::: "memory");
        }
      }
    }
}
struct EpiBF16 { static constexpr int GROUP = 16; bf16_t* C; size_t ldc; DI void operator()(int m, int n, float v) const { C[(size_t)m * ldc + n] = f2bf(v); } };
struct EpiF32  { static constexpr int GROUP = 16; float* C; size_t ldc; DI void operator()(int m, int n, float v) const { C[(size_t)m * ldc + n] = v; } };
struct EpiW { static constexpr int GROUP = 16; float* W; const float* w0; int d;
  DI void operator()(int m, int n, float v) const { W[((size_t)m * 2 + d) * 1024 + n] = __expf(-0.6065306597f * sigmoidf_(w0[d * 1024 + n] + v)); } };
struct EpiA { static constexpr int GROUP = 16; float* KKA; const float* a0; int d;
  DI void operator()(int m, int n, float v) const { KKA[((size_t)m * 2 + d) * 1024 + n] = sigmoidf_(a0[d * 1024 + n] + v); } };
struct EpiRes { static constexpr int GROUP = 16; const float* xp; const float* xs; const float* gt; float* out;
  DI void operator()(int m, int n, float v) const {
    const float xin = m < TP ? xp[(size_t)m * 2048 + n] : xs[(size_t)(m - TP) * 2048 + n];
    out[(size_t)m * 2048 + n] = xin + gt[cvec_of(m) * 12288 + n] * v; } };

template <int BN, class Epi>
DI void gemm_full(const bf16_t* A, int lda, const bf16_t* Bt, int ldb, int M, int N, int K, const Epi& epi, char* lds) {
  const int tn = (N + BN - 1) / BN, ntile = (M / 256) * tn;
  for (int tile = blockIdx.x; tile < ntile; tile += gridDim.x) gemm_tile<BN>(A, lda, Bt, ldb, (tile / tn) * 256, (tile % tn) * BN, N, K, epi, lds);
}

constexpr int AD = 128, ANW = 8, AQBLK = 32, AKVBLK = 64;
constexpr float ASCALE = 0.088388347648318440f;
constexpr float ATHR = 8.f;
constexpr size_t SHM_V = AKVBLK * AD * 2, SHM_K = AKVBLK * AD * 2, SHM_ATTN = 2 * SHM_V + 2 * SHM_K + ANW * 64 * 4;
#define KSWZ(row, colB) ((row) * 256 + ((colB) ^ (((row) & 7) << 4)))
#define SBAR() __builtin_amdgcn_sched_barrier(0)
DI unsigned cvtpk(float lo, float hi) { unsigned r; asm volatile("v_cvt_pk_bf16_f32 %0, %1, %2" : "=v"(r) : "v"(lo), "v"(hi)); return r; }
DI void partialSM(f32x16& p0, f32x16& p1, float& m_reg, float& mn, float& alpha) {
  constexpr float C = ASCALE * 1.4426950408889634f;
  float pmax = p0[0];
#pragma unroll
  for (int r = 1; r < 16; ++r) pmax = fmaxf(pmax, p0[r]);
#pragma unroll
  for (int r = 0; r < 16; ++r) pmax = fmaxf(pmax, p1[r]);
  { auto rr = __builtin_amdgcn_permlane32_swap(__float_as_uint(pmax), __float_as_uint(pmax), false, false);
    pmax = fmaxf(__uint_as_float(rr[0]), __uint_as_float(rr[1])); }
  if (__builtin_expect(__all(pmax - m_reg <= ATHR / ASCALE), 1)) { mn = m_reg; alpha = 1.f; }
  else { mn = fmaxf(m_reg, pmax); alpha = __builtin_amdgcn_exp2f((m_reg - mn) * C); m_reg = mn; }
  float mnC = -mn * C;
#pragma unroll
  for (int r = 0; r < 16; ++r) p0[r] = fmaf(p0[r], C, mnC);
#pragma unroll
  for (int r = 0; r < 16; ++r) p1[r] = fmaf(p1[r], C, mnC);
#pragma unroll
  for (int r = 0; r < 16; ++r) p0[r] = __builtin_amdgcn_exp2f(p0[r]);
}
DI void finishSM(f32x16& p0, f32x16& p1, float alpha, float& l_reg, bf16x8& pa0, bf16x8& pa1, bf16x8& pa2, bf16x8& pa3) {
#pragma unroll
  for (int r = 0; r < 16; ++r) p1[r] = __builtin_amdgcn_exp2f(p1[r]);
  float ps = 0;
#pragma unroll
  for (int r = 0; r < 16; ++r) ps += p0[r];
#pragma unroll
  for (int r = 0; r < 16; ++r) ps += p1[r];
  { auto rr = __builtin_amdgcn_permlane32_swap(__float_as_uint(ps), __float_as_uint(ps), false, false);
    ps = __uint_as_float(rr[0]) + __uint_as_float(rr[1]); }
  l_reg = l_reg * alpha + ps;
#define PK4(P, BASE, OUT) do { unsigned a0 = cvtpk(P[BASE + 0], P[BASE + 1]), a1 = cvtpk(P[BASE + 2], P[BASE + 3]);   \
    unsigned b0 = cvtpk(P[BASE + 4], P[BASE + 5]), b1 = cvtpk(P[BASE + 6], P[BASE + 7]);                              \
    auto r0 = __builtin_amdgcn_permlane32_swap(a0, b0, false, false); auto r1 = __builtin_amdgcn_permlane32_swap(a1, b1, false, false); \
    u32x4 w = {r0[0], r1[0], r0[1], r1[1]}; OUT = *reinterpret_cast<bf16x8*>(&w); } while (0)
  PK4(p0, 0, pa0); PK4(p0, 8, pa1); PK4(p1, 0, pa2); PK4(p1, 8, pa3);
#undef PK4
}
DI void qkt(f32x16& p0, f32x16& p1, const bf16_t* Ks, const bf16x8* qr, int r32, int hi) {
#pragma unroll
  for (int r = 0; r < 16; ++r) { p0[r] = 0.f; p1[r] = 0.f; }
#pragma unroll
  for (int d0 = 0; d0 < 8; ++d0) { int cb = (d0 * 16 + hi * 8) * 2;
    bf16x8 b0 = *reinterpret_cast<const bf16x8*>((const char*)Ks + KSWZ(r32, cb));
    bf16x8 b1 = *reinterpret_cast<const bf16x8*>((const char*)Ks + KSWZ(32 + r32, cb));
    p0 = __builtin_amdgcn_mfma_f32_32x32x16_bf16(b0, qr[d0], p0, 0, 0, 0);
    p1 = __builtin_amdgcn_mfma_f32_32x32x16_bf16(b1, qr[d0], p1, 0, 0, 0); }
}
DI int v_st(int k, int c) { const int kk = (k & ~0xC) | ((k & 4) << 1) | ((k & 8) >> 1); return ((kk >> 3) * 4 + (c >> 5)) * 512 + ((kk & 7) * 32 + (c & 31)) * 2; }
DI int v_rd_base(int lane) { return ((lane & 3) << 3) | (((lane >> 2) & 3) << 6) | (((lane >> 4) & 1) << 5) | (((lane >> 5) & 1) << 8); }
constexpr int v_rd_off(int d0, int ks, int half) { return d0 * 512 + ks * 4096 + half * 2048; }
template <int OFF> DI s16x4 tr_read(int vb) {
  s16x4 r; asm volatile("ds_read_b64_tr_b16 %0, %1 offset:%2" : "=&v"(r) : "v"(vb), "i"(OFF) : "memory"); return r;
}
template <int D0> DI void pv_one(f32x16& od, int vb, bf16x8 pa0, bf16x8 pa1, bf16x8 pa2, bf16x8 pa3) {
  const s16x4 l0 = tr_read<v_rd_off(D0, 0, 0)>(vb), h0 = tr_read<v_rd_off(D0, 0, 1)>(vb), l1 = tr_read<v_rd_off(D0, 1, 0)>(vb), h1 = tr_read<v_rd_off(D0, 1, 1)>(vb);
  const s16x4 l2 = tr_read<v_rd_off(D0, 2, 0)>(vb), h2 = tr_read<v_rd_off(D0, 2, 1)>(vb), l3 = tr_read<v_rd_off(D0, 3, 0)>(vb), h3 = tr_read<v_rd_off(D0, 3, 1)>(vb);
  asm volatile("s_waitcnt lgkmcnt(0)" ::: "memory"); SBAR();
#define PK(L, H) (bf16x8){L[0], L[1], L[2], L[3], H[0], H[1], H[2], H[3]}
  od = __builtin_amdgcn_mfma_f32_32x32x16_bf16(pa0, PK(l0, h0), od, 0, 0, 0);
  od = __builtin_amdgcn_mfma_f32_32x32x16_bf16(pa1, PK(l1, h1), od, 0, 0, 0);
  od = __builtin_amdgcn_mfma_f32_32x32x16_bf16(pa2, PK(l2, h2), od, 0, 0, 0);
  od = __builtin_amdgcn_mfma_f32_32x32x16_bf16(pa3, PK(l3, h3), od, 0, 0, 0);
#undef PK
}
DI void pv_d0(f32x16* o, int vb, bf16x8 pa0, bf16x8 pa1, bf16x8 pa2, bf16x8 pa3) {
  pv_one<0>(o[0], vb, pa0, pa1, pa2, pa3); pv_one<1>(o[1], vb, pa0, pa1, pa2, pa3); pv_one<2>(o[2], vb, pa0, pa1, pa2, pa3); pv_one<3>(o[3], vb, pa0, pa1, pa2, pa3);
}
template <int LDQ, int LDK, int LDO>
DI void attn_dense_body(const bf16_t* __restrict__ Qb, const bf16_t* __restrict__ Kh, const bf16_t* __restrict__ Vh,
                        bf16_t* __restrict__ Ob, int seq, char* lds) {
  const int tid = tid_(), wid = tid >> 6, lane = tid & 63, r32 = lane & 31, hi = lane >> 5;
  bf16_t* V_lds = (bf16_t*)lds; bf16_t* K_lds = (bf16_t*)(lds + 2 * SHM_V);
  float* wsf = (float*)(lds + 2 * SHM_V + 2 * SHM_K) + wid * 64; float* li_l = wsf; float* al_l = wsf + 32;
  float m_reg = -1e30f, l_reg = 0; f32x16 o[4]; bf16x8 qr[8];
#pragma unroll
  for (int d = 0; d < 4; d++)
#pragma unroll
    for (int r = 0; r < 16; r++) o[d][r] = 0.f;
  const bf16_t* Qw = Qb + (long)(wid * AQBLK + r32) * LDQ + hi * 8;
#pragma unroll
  for (int d0 = 0; d0 < 8; ++d0) qr[d0] = *reinterpret_cast<const bf16x8*>(Qw + d0 * 16);
  const int sr = tid >> 4, sc = (tid & 15) * 8, vst0 = v_st(sr, sc), vst1 = v_st(32 + sr, sc);
  const int vb0 = (int)(uintptr_t)V_lds + v_rd_base(lane);
  struct { bf16x8 vs0, vs1, ks0, ks1; } sr_[2];
#define SLOAD(i, k0) do { sr_[i].vs0 = *(const bf16x8*)(&Vh[(long)((k0) + sr) * LDK + sc]); sr_[i].vs1 = *(const bf16x8*)(&Vh[(long)((k0) + 32 + sr) * LDK + sc]); \
    sr_[i].ks0 = *(const bf16x8*)(&Kh[(long)((k0) + sr) * LDK + sc]); sr_[i].ks1 = *(const bf16x8*)(&Kh[(long)((k0) + 32 + sr) * LDK + sc]); } while (0)
#define SWRITE(b, i) do { *(bf16x8*)((char*)V_lds + (b) * SHM_V + vst0) = sr_[i].vs0;          \
    *(bf16x8*)((char*)V_lds + (b) * SHM_V + vst1) = sr_[i].vs1; int kc = sc * 2;               \
    *(bf16x8*)((char*)K_lds + (b) * SHM_K + KSWZ(sr, kc)) = sr_[i].ks0;                       \
    *(bf16x8*)((char*)K_lds + (b) * SHM_K + KSWZ(32 + sr, kc)) = sr_[i].ks1; } while (0)
#define SWAIT() do { asm volatile("s_waitcnt vmcnt(4)" ::: "memory"); } while (0)
#define RESC(a) do { if (__any((a) < 1.f)) { if (hi == 0) al_l[r32] = (a); asm volatile("s_waitcnt lgkmcnt(0)" ::: "memory"); \
    _Pragma("unroll") for (int d = 0; d < 4; ++d) _Pragma("unroll") for (int r = 0; r < 16; ++r) o[d][r] *= al_l[crow(r, hi)]; } } while (0)
  f32x16 pA0, pA1, pB0, pB1; float mnA, mnB, alA, alB; bf16x8 pa0, pa1, pa2, pa3; const int NTL = seq / AKVBLK;
  constexpr int SE = 0, SO = 1;
  SLOAD(SE, 0); asm volatile("s_waitcnt vmcnt(0)" ::: "memory"); SWRITE(0, SE); __syncthreads();
  qkt(pA0, pA1, K_lds, qr, r32, hi); partialSM(pA0, pA1, m_reg, mnA, alA);
  SLOAD(SO, AKVBLK); if (2 < NTL) SLOAD(SE, 2 * AKVBLK);
  SWAIT(); SWRITE(1, SO); __syncthreads();
  for (int j = 1; j + 1 < NTL; j += 2) {
    SBAR(); qkt(pB0, pB1, (bf16_t*)((char*)K_lds + SHM_K), qr, r32, hi);
    finishSM(pA0, pA1, alA, l_reg, pa0, pa1, pa2, pa3); SBAR();
    SLOAD(SO, (j + 2) * AKVBLK); SBAR();
    pv_d0(o, vb0, pa0, pa1, pa2, pa3); partialSM(pB0, pB1, m_reg, mnB, alB);
    __syncthreads(); SWAIT(); SWRITE(0, SE);
    RESC(alB); __syncthreads();
    SBAR(); qkt(pA0, pA1, K_lds, qr, r32, hi);
    finishSM(pB0, pB1, alB, l_reg, pa0, pa1, pa2, pa3); SBAR();
    if (j + 3 < NTL) SLOAD(SE, (j + 3) * AKVBLK); SBAR();
    pv_d0(o, vb0 + (int)SHM_V, pa0, pa1, pa2, pa3); partialSM(pA0, pA1, m_reg, mnA, alA);
    __syncthreads(); SWAIT(); SWRITE(1, SO);
    RESC(alA); __syncthreads();
  }
  SBAR(); qkt(pB0, pB1, (bf16_t*)((char*)K_lds + SHM_K), qr, r32, hi);
  finishSM(pA0, pA1, alA, l_reg, pa0, pa1, pa2, pa3); SBAR();
  pv_d0(o, vb0, pa0, pa1, pa2, pa3); partialSM(pB0, pB1, m_reg, mnB, alB);
  __syncthreads(); RESC(alB);
  finishSM(pB0, pB1, alB, l_reg, pa0, pa1, pa2, pa3); SBAR();
  pv_d0(o, vb0 + (int)SHM_V, pa0, pa1, pa2, pa3);
  if (hi == 0) li_l[r32] = l_reg; asm volatile("s_waitcnt lgkmcnt(0)" ::: "memory");
  float rli[16];
#pragma unroll
  for (int r = 0; r < 16; ++r) rli[r] = __builtin_amdgcn_rcpf(li_l[crow(r, hi)]);
  bf16_t* Ow = Ob + (long)(wid * AQBLK) * LDO;
#pragma unroll
  for (int r = 0; r < 16; ++r) { int orow = crow(r, hi);
#pragma unroll
    for (int d0 = 0; d0 < 4; ++d0) { const float ov = o[d0][r] * rli[r]; Ow[(long)orow * LDO + d0 * 32 + r32] = (bf16_t)(cvtpk(ov, ov) & 0xffffu); } }
#undef SLOAD
#undef SWRITE
#undef SWAIT
#undef RESC
}

DI void phase_prep0(const Params& p, char* lds) {
  const bf16_t* z0 = (const bf16_t*)(p.ws + WS_Z0);
  bf16_t* Qb = (bf16_t*)(p.ws + WS_QB);
  bf16_t* Kbp = (bf16_t*)(p.ws + WS_KBP); bf16_t* Vbp = (bf16_t*)(p.ws + WS_VBP);
  bf16_t* Kbs = (bf16_t*)(p.ws + WS_KBS); bf16_t* Vbs = (bf16_t*)(p.ws + WS_VBS);
  const float* qn = p.in[IN_EB_QN]; const float* kn = p.in[IN_EB_KN];
  float* outk = p.out + OUT_NK; float* outv = p.out + OUT_NV;
  const int tid = tid_(), lane = tid & 63, wave = tid >> 6;
  float* R = (float*)(p.ws + WS_R); float* KK = (float*)(p.ws + WS_KK); float* V = (float*)(p.ws + WS_V);
  float* KT = (float*)(p.ws + WS_KT);
  float* BON = (float*)(p.ws + WS_BON); bf16_t* actA = (bf16_t*)(p.ws + WS_ACTA);
  const float* k_k = p.in[IN_EA_KK]; const float* r_k = p.in[IN_EA_RK];
  float* cwl = (float*)lds;
  __syncthreads();
  for (int i = tid; i < 3 * 3456; i += NTH) cwl[i] = p.in[IN_EA_CONV][i];
  __syncthreads();
  for (int t = blockIdx.x * 8 + wave; t < T; t += gridDim.x * 8) {
    const bf16_t* zr = z0 + (size_t)t * ZC;
    const bool latent = t >= TP;
    const int tl = latent ? ((t - TP) & 4095) : (t & 255);
    const int L = latent ? 4096 : 256;
    const bool hasp = tl > 0, hasn = tl < L - 1;
    const float hp = hasp ? 1.f : 0.f, hn = hasn ? 1.f : 0.f;
    const bf16_t* zpr = hasp ? zr - ZC : zr; const bf16_t* znr = hasn ? zr + ZC : zr;
    float ze[20];
#pragma unroll
    for (int hh = 0; hh < 10; hh++) { ze[2 * hh] = bf2f(zr[3456 + hh * 128 + lane]); ze[2 * hh + 1] = bf2f(zr[3456 + hh * 128 + 64 + lane]); }
    const u32x2 vraw = *(const u32x2*)&zr[3456 + 1280 + lane * 4];
    u32x4 zz[3][2][3];
#pragma unroll
    for (int sec = 0; sec < 3; sec++)
#pragma unroll
      for (int hv = 0; hv < 2; hv++) {
        const int col = sec * 1024 + lane * 16 + hv * 8;
        zz[sec][hv][0] = *(const u32x4*)&zpr[col]; zz[sec][hv][1] = *(const u32x4*)&zr[col]; zz[sec][hv][2] = *(const u32x4*)&znr[col];
      }
    u32x4 zl[3];
    { const int col = 3072 + (lane < 48 ? lane : 0) * 8;
      zl[0] = *(const u32x4*)&zpr[col]; zl[1] = *(const u32x4*)&zr[col]; zl[2] = *(const u32x4*)&znr[col]; }
    {
      float cs0 = 1.f, sn0 = 0.f, cs1 = 1.f, sn1 = 0.f;
      if (latent) {
        const int i = lane & 31;
        const float inv = exp2f(-(float)i * 0.41524101186092029f);
        const float a0 = (float)(tl >> 6) * inv, a1 = (float)(tl & 63) * inv;
        cs0 = __cosf(a0); sn0 = __sinf(a0); cs1 = __cosf(a1); sn1 = __sinf(a1);
      }
      const float g0q = qn[lane], g1q = qn[64 + lane], g0k = kn[lane], g1k = kn[64 + lane];
#pragma unroll
      for (int hh = 0; hh < 10; hh++) {
        float e0 = ze[2 * hh], e1 = ze[2 * hh + 1];
        const float ss = wave_sum(e0 * e0 + e1 * e1);
        const float rstd = rsqrtf(ss * (1.f / 128.f) + 1e-6f);
        const bool isq = hh < 8;
        e0 *= rstd * (isq ? g0q : g0k); e1 *= rstd * (isq ? g1q : g1k);
        if (!isq && !latent) {
          const size_t o = (size_t)t * 256 + (hh - 8) * 128;
          outk[o + lane] = e0; outk[o + 64 + lane] = e1;
        }
        if (latent) {
          const float p0 = __shfl_xor(e0, 32), p1 = __shfl_xor(e1, 32);
          if (lane < 32) { e0 = e0 * cs0 - p0 * sn0; e1 = e1 * cs1 - p1 * sn1; }
          else           { e0 = p0 * sn0 + e0 * cs0; e1 = p1 * sn1 + e1 * cs1; }
        }
        if (isq) {
          bf16_t* q = Qb + (size_t)t * 1024 + hh * 128; q[lane] = f2bf(e0); q[64 + lane] = f2bf(e1);
        } else {
          bf16_t* k;
          if (!latent) k = Kbp + (size_t)t * 256 + (hh - 8) * 128;
          else { const int b = (t - TP) >> 12; k = Kbs + ((size_t)b * SKV_S + tl) * 256 + (hh - 8) * 128; }
          k[lane] = f2bf(e0); k[64 + lane] = f2bf(e1);
        }
      }
      {
        bf16_t* vd;
        if (!latent) {
          vd = Vbp + (size_t)t * 256 + lane * 4;
          float4 f = {lo2f(vraw[0]), hi2f(vraw[0]), lo2f(vraw[1]), hi2f(vraw[1])};
          *(float4*)&outv[(size_t)t * 256 + lane * 4] = f;
        } else { const int b = (t - TP) >> 12; vd = Vbs + ((size_t)b * SKV_S + tl) * 256 + lane * 4; }
        *(u32x2*)vd = vraw;
      }
    }
    {
      const int c0 = lane * 16;
      auto conv_sec = [&](int sec, float* dst) {
#pragma unroll
        for (int hv = 0; hv < 2; hv++) {
          const int col = sec * 1024 + lane * 16 + hv * 8;
          float zc[8], zp[8], zn[8];
          unpack8(zz[sec][hv][0], zp); unpack8(zz[sec][hv][1], zc); unpack8(zz[sec][hv][2], zn);
#pragma unroll
          for (int e4 = 0; e4 < 2; e4++) {
            const float4 w0 = *(const float4*)&cwl[col + e4 * 4], w1 = *(const float4*)&cwl[3456 + col + e4 * 4], w2 = *(const float4*)&cwl[6912 + col + e4 * 4];
            dst[hv * 8 + e4 * 4 + 0] = hp * zp[e4 * 4 + 0] * w0.x + zc[e4 * 4 + 0] * w1.x + hn * zn[e4 * 4 + 0] * w2.x;
            dst[hv * 8 + e4 * 4 + 1] = hp * zp[e4 * 4 + 1] * w0.y + zc[e4 * 4 + 1] * w1.y + hn * zn[e4 * 4 + 1] * w2.y;
            dst[hv * 8 + e4 * 4 + 2] = hp * zp[e4 * 4 + 2] * w0.z + zc[e4 * 4 + 2] * w1.z + hn * zn[e4 * 4 + 2] * w2.z;
            dst[hv * 8 + e4 * 4 + 3] = hp * zp[e4 * 4 + 3] * w0.w + zc[e4 * 4 + 3] * w1.w + hn * zn[e4 * 4 + 3] * w2.w;
          }
        }
      };
      float kk[16], tmp[16];
      conv_sec(1, kk);
      float ss = 0.f;
#pragma unroll
      for (int e = 0; e < 16; e++) { tmp[e] = kk[e] * k_k[c0 + e]; ss += tmp[e] * tmp[e]; }
      ss += __shfl_xor(ss, 1); ss += __shfl_xor(ss, 2);
      const float rn = rsqrtf(ss + 1e-12f);
#pragma unroll
      for (int e = 0; e < 16; e++) tmp[e] *= rn;
#pragma unroll
      for (int e4 = 0; e4 < 4; e4++) {
        const size_t o1 = (size_t)t * 1024 + c0 + e4 * 4, o2 = (size_t)t * 2048 + c0 + e4 * 4;
        const float4 k4 = {kk[e4 * 4], kk[e4 * 4 + 1], kk[e4 * 4 + 2], kk[e4 * 4 + 3]};
        const float4 n4 = {tmp[e4 * 4], tmp[e4 * 4 + 1], tmp[e4 * 4 + 2], tmp[e4 * 4 + 3]};
        *(float4*)&KK[o1] = n4;
        *(float4*)&KT[o2] = k4;
      }
      conv_sec(0, tmp);
      float bs = 0.f;
#pragma unroll
      for (int e = 0; e < 16; e++) bs += tmp[e] * kk[e] * r_k[c0 + e];
      bs += __shfl_xor(bs, 1); bs += __shfl_xor(bs, 2);
      if ((lane & 3) == 0) BON[(size_t)t * 16 + (lane >> 2)] = bs;
#pragma unroll
      for (int e4 = 0; e4 < 4; e4++) {
        const float4 r4 = {tmp[e4 * 4], tmp[e4 * 4 + 1], tmp[e4 * 4 + 2], tmp[e4 * 4 + 3]};
        *(float4*)&R[(size_t)t * 1024 + c0 + e4 * 4] = r4;
      }
      conv_sec(2, tmp);
#pragma unroll
      for (int e4 = 0; e4 < 4; e4++) {
        const float4 v4 = {tmp[e4 * 4], tmp[e4 * 4 + 1], tmp[e4 * 4 + 2], tmp[e4 * 4 + 3]};
        *(float4*)&V[(size_t)t * 1024 + c0 + e4 * 4] = v4;
      }
      if (lane < 48) {
        const int col = 3072 + lane * 8;
        float zc[8], zp[8], zn[8];
        unpack8(zl[0], zp); unpack8(zl[1], zc); unpack8(zl[2], zn);
        float o[8];
#pragma unroll
        for (int e = 0; e < 8; e++) {
          float x = hp * zp[e] * cwl[col + e] + zc[e] * cwl[3456 + col + e] + hn * zn[e] * cwl[6912 + col + e];
          if (lane < 16) x = tanhf(x); else if (lane >= 32) x = sigmoidf_(x);
          o[e] = x;
        }
        u32x4 ov = {pack2(o[0], o[1]), pack2(o[2], o[3]), pack2(o[4], o[5]), pack2(o[6], o[7])};
        *(u32x4*)&actA[(size_t)t * 384 + lane * 8] = ov;
      }
    }
  }
  {
    const float* ck = p.in[IN_CACHE_K]; const float* cvv = p.in[IN_CACHE_V];
    for (int i = blockIdx.x * NTH + tid_(); i < 2 * 512 * 256; i += gridDim.x * NTH) {
      const int b = i / (512 * 256), rem = i % (512 * 256);
      const size_t o = ((size_t)b * SKV_S + 4096) * 256 + rem;
      Kbs[o] = f2bf(ck[i]); Vbs[o] = f2bf(cvv[i]);
    }
  }
}

DI void phase_fixa(const Params& p) {
  float* KKA = (float*)(p.ws + WS_KKA); float* KT = (float*)(p.ws + WS_KT); const float* KK = (const float*)(p.ws + WS_KK); const float* ka = p.in[IN_EA_KA];
  for (int i = blockIdx.x * NTH + tid_(); i < T * 256; i += gridDim.x * NTH) {
    const int t = i >> 8, n = (i & 255) * 4;
    const size_t o1 = (size_t)t * 1024 + n, o2 = (size_t)t * 2048 + n;
    const float4 kk = *(const float4*)&KK[o1], k = *(const float4*)&KT[o2], a0 = *(const float4*)&KKA[o2], a1 = *(const float4*)&KKA[o2 + 1024], c = *(const float4*)&ka[n];
    float4 r;
    r.x = kk.x * a0.x; r.y = kk.y * a0.y; r.z = kk.z * a0.z; r.w = kk.w * a0.w; *(float4*)&KKA[o2] = r;
    r.x = kk.x * a1.x; r.y = kk.y * a1.y; r.z = kk.z * a1.z; r.w = kk.w * a1.w; *(float4*)&KKA[o2 + 1024] = r;
    r.x = k.x * (1.f + (a0.x - 1.f) * c.x); r.y = k.y * (1.f + (a0.y - 1.f) * c.y); r.z = k.z * (1.f + (a0.z - 1.f) * c.z); r.w = k.w * (1.f + (a0.w - 1.f) * c.w); *(float4*)&KT[o2] = r;
    r.x = k.x * (1.f + (a1.x - 1.f) * c.x); r.y = k.y * (1.f + (a1.y - 1.f) * c.y); r.z = k.z * (1.f + (a1.z - 1.f) * c.z); r.w = k.w * (1.f + (a1.w - 1.f) * c.w); *(float4*)&KT[o2 + 1024] = r;
  }
}

typedef float f2v __attribute__((ext_vector_type(2)));
template <int RPL> struct ScanBuf { f2v kk[2], w[2], kka[2], kt[2], r[2]; float v[RPL]; };
template <int RPL, int DEP>
DI void scan_item(const Params& p, int tok0, int L, int dir, int head, int row0, const float* s0, float* sfin) {
  const int lane = tid_() & 63;
  const int g = lane >> 4, kq = lane & 15, k0 = kq * 4, rbase = row0 + g * RPL;
  const char* Rb = p.ws + WS_R; const char* KKb = p.ws + WS_KK; const char* Vb = p.ws + WS_V;
  const char* Wb = p.ws + WS_W; const char* KKAb = p.ws + WS_KKA; const char* KTb = p.ws + WS_KT;
  char* Yb = (char*)p.out;
  const unsigned c1 = (unsigned)(head * 64 + k0) * 4u, cv = (unsigned)(head * 64 + rbase) * 4u;
  const unsigned c2 = (unsigned)(dir * 1024 + head * 64 + k0) * 4u, cy = (unsigned)(dir * 1024 + head * 64 + rbase + (kq < RPL ? kq : 0)) * 4u;
  f2v S[RPL][2];
#pragma unroll
  for (int j = 0; j < RPL; j++)
#pragma unroll
    for (int e = 0; e < 2; e++) {
      S[j][e][0] = s0 ? s0[(rbase + j) * 64 + k0 + 2 * e] : 0.f; S[j][e][1] = s0 ? s0[(rbase + j) * 64 + k0 + 2 * e + 1] : 0.f;
    }
  ScanBuf<RPL> buf[DEP];
  auto load = [&](ScanBuf<RPL>& b, int step) {
    const unsigned tok = (unsigned)(tok0 + (dir ? L - 1 - step : step));
    const unsigned o1 = tok * 4096u + c1, o2 = tok * 8192u + c2;
    const float4 a = *(const float4*)(KKb + o1); b.kk[0] = f2v{a.x, a.y}; b.kk[1] = f2v{a.z, a.w};
    const float4 c = *(const float4*)(Rb + o1); b.r[0] = f2v{c.x, c.y}; b.r[1] = f2v{c.z, c.w};
    const float4 d = *(const float4*)(Wb + o2); b.w[0] = f2v{d.x, d.y}; b.w[1] = f2v{d.z, d.w};
    const float4 f = *(const float4*)(KKAb + o2); b.kka[0] = f2v{f.x, f.y}; b.kka[1] = f2v{f.z, f.w};
    const float4 h = *(const float4*)(KTb + o2); b.kt[0] = f2v{h.x, h.y}; b.kt[1] = f2v{h.z, h.w};
    if constexpr (RPL == 2) { const float2 v = *(const float2*)(Vb + tok * 4096u + cv); b.v[0] = v.x; b.v[1] = v.y; }
    else { const float4 v = *(const float4*)(Vb + tok * 4096u + cv); b.v[0] = v.x; b.v[1] = v.y; b.v[2] = v.z; b.v[3] = v.w; }
  };
#pragma unroll
  for (int d = 0; d < DEP; d++) { load(buf[d], d); __builtin_amdgcn_sched_barrier(0); }
  for (int sb = 0; sb < L; sb += DEP) {
#pragma unroll
    for (int d = 0; d < DEP; d++) {
      const int step = sb + d;
      ScanBuf<RPL>& b = buf[d];
      float sa[RPL], y[RPL];
#pragma unroll
      for (int j = 0; j < RPL; j++) { const f2v t = S[j][0] * b.kk[0] + S[j][1] * b.kk[1]; sa[j] = t[0] + t[1]; }
#pragma unroll
      for (int j = 0; j < RPL; j++) sa[j] = row_reduce<16>(sa[j]);
#pragma unroll
      for (int j = 0; j < RPL; j++) {
        const f2v nsa = {-sa[j], -sa[j]}, vv = {b.v[j], b.v[j]};
        f2v t0 = vv * b.kt[0], t1 = vv * b.kt[1];
        t0 = nsa * b.kka[0] + t0; t1 = nsa * b.kka[1] + t1;
        S[j][0] = S[j][0] * b.w[0] + t0; S[j][1] = S[j][1] * b.w[1] + t1;
        const f2v ya = S[j][0] * b.r[0] + S[j][1] * b.r[1];
        y[j] = ya[0] + ya[1];
      }
#pragma unroll
      for (int j = 0; j < RPL; j++) y[j] = row_reduce<16>(y[j]);
      float ysel = y[0];
#pragma unroll
      for (int j = 1; j < RPL; j++) ysel = (kq == j) ? y[j] : ysel;
      const unsigned tok = (unsigned)(tok0 + (dir ? L - 1 - step : step));
      if (kq < RPL) *(float*)(Yb + tok * 8192u + cy) = ysel;
      __builtin_amdgcn_sched_barrier(0);
      load(b, step + DEP < L ? step + DEP : L - 1);
      __builtin_amdgcn_sched_barrier(0);
    }
  }
  if (sfin) {
#pragma unroll
    for (int j = 0; j < RPL; j++)
#pragma unroll
      for (int e = 0; e < 2; e++) { sfin[(rbase + j) * 64 + k0 + 2 * e] = S[j][e][0]; sfin[(rbase + j) * 64 + k0 + 2 * e + 1] = S[j][e][1]; }
  }
}
DI void phase_scan(const Params& p, char* lds) {
  const int wave = tid_() >> 6;
  if (wave < 2) {
    for (int it = blockIdx.x * 2 + wave; it < 512; it += gridDim.x * 2) {
      const int rg = it & 7, hsd = it >> 3, head = hsd & 15, dir = (hsd >> 4) & 1, b = hsd >> 5;
      const float* s0 = p.in[IN_STATE_A] + ((size_t)(b * 2 + dir) * 16 + head) * 4096;
      scan_item<2, 8>(p, TP + b * 4096, 4096, dir, head, rg * 8, s0, nullptr);
    }
  } else if ((wave & 3) >= 2) {
    const int w4 = (wave & 1) + ((wave >> 2) << 1);
    for (int it = blockIdx.x * 4 + w4; it < 4096; it += gridDim.x * 4) {
      const int rg = it & 3, hsd = it >> 2, head = hsd & 15, dir = (hsd >> 4) & 1, b = hsd >> 5;
      float* sf = p.out + OUT_NS + ((size_t)(b * 2 + dir) * 16 + head) * 4096;
      scan_item<4, 4>(p, b * 256, 256, dir, head, rg * 16, nullptr, sf);
    }
    const int widx = blockIdx.x * 4 + w4, nw = gridDim.x * 4;
    float* wl = (float*)lds + w4 * (64 * 65);
    transpose_tiles_w(p.in[IN_EW_OUT], (bf16_t*)(p.ws + WS_WT_OUT0), 2048, 2048, wl, widx, nw);
    convert_fp8_rows_w(p.in[IN_PEER_U], (unsigned char*)(p.ws + WS_UB), (float*)(p.ws + WS_TSC), 32768, widx, nw);
    convert_fp8_rows_w(p.in[IN_PEER_V], (unsigned char*)(p.ws + WS_VB), (float*)(p.ws + WS_TSC) + 32768, 32768, widx, nw);
    transpose_tiles_w(p.in[IN_PEER_WQ], (bf16_t*)(p.ws + WS_WT_Q), 2048, 2048, wl, widx, nw);
    transpose_tiles_w(p.in[IN_OW_IN], (bf16_t*)(p.ws + WS_WT_IN1), 2048, 6144, wl, widx, nw);
    transpose_tiles_w(p.in[IN_OW_OUT], (bf16_t*)(p.ws + WS_WT_OUT1), 2048, 2048, wl, widx, nw);
    transpose_tiles_w(p.in[IN_PEER_WQ] + (size_t)2048 * 2048, (bf16_t*)(p.ws + WS_WT_Q) + (size_t)2048 * 2048, 2048, 2048, wl, widx, nw);
    transpose_tiles_w(p.in[IN_OC_FW3], (bf16_t*)(p.ws + WS_FW3T), 64, 8192, wl, widx, nw);
  }
}

DI void phase_post0(const Params& p) {
  const float* ydir = p.out; const float* V = (const float*)(p.ws + WS_V); const float* G = (const float*)(p.ws + WS_G);
  const float* BON = (const float*)(p.ws + WS_BON); const float* lnw = p.in[IN_EA_LNW]; const float* lnb = p.in[IN_EA_LNB];
  bf16_t* A2 = (bf16_t*)(p.ws + WS_A2);
  const int lane = tid_() & 63, wave = tid_() >> 6;
  for (int t = blockIdx.x * 8 + wave; t < T; t += gridDim.x * 8) {
    const int c0 = lane * 16;
    float y[16]; float s = 0.f;
#pragma unroll
    for (int e4 = 0; e4 < 4; e4++) {
      const float4 a = *(const float4*)&ydir[(size_t)t * 2048 + c0 + e4 * 4], b = *(const float4*)&ydir[(size_t)t * 2048 + 1024 + c0 + e4 * 4];
      y[e4 * 4] = a.x + b.x; y[e4 * 4 + 1] = a.y + b.y; y[e4 * 4 + 2] = a.z + b.z; y[e4 * 4 + 3] = a.w + b.w;
    }
#pragma unroll
    for (int e = 0; e < 16; e++) s += y[e];
    s += __shfl_xor(s, 1); s += __shfl_xor(s, 2);
    const float mu = s * (1.f / 64.f);
    float vs = 0.f;
#pragma unroll
    for (int e = 0; e < 16; e++) { const float d = y[e] - mu; vs += d * d; }
    vs += __shfl_xor(vs, 1); vs += __shfl_xor(vs, 2);
    const float rstd = rsqrtf(vs * (1.f / 64.f) + 64e-5f);
    const float bon = BON[(size_t)t * 16 + (lane >> 2)];
    float o[16];
#pragma unroll
    for (int e = 0; e < 16; e++) {
      const float yn = (y[e] - mu) * rstd * lnw[c0 + e] + lnb[c0 + e];
      o[e] = (yn + bon * V[(size_t)t * 1024 + c0 + e]) * G[(size_t)t * 1024 + c0 + e];
    }
    u32x4 o0 = {pack2(o[0], o[1]), pack2(o[2], o[3]), pack2(o[4], o[5]), pack2(o[6], o[7])};
    u32x4 o1 = {pack2(o[8], o[9]), pack2(o[10], o[11]), pack2(o[12], o[13]), pack2(o[14], o[15])};
    *(u32x4*)&A2[(size_t)t * 2048 + c0] = o0; *(u32x4*)&A2[(size_t)t * 2048 + c0 + 8] = o1;
  }
}

template <int CTRL> DI unsigned dppu(unsigned x) { return (unsigned)__builtin_amdgcn_update_dpp(0, (int)x, CTRL, 0xf, 0xf, false); }
DI unsigned wave_max_u(unsigned v) {
  v = max(v, dppu<0xB1>(v)); v = max(v, dppu<0x4E>(v)); v = max(v, dppu<0x141>(v)); v = max(v, dppu<0x140>(v));
  const unsigned a = __builtin_amdgcn_readlane((int)v, 0), b = __builtin_amdgcn_readlane((int)v, 16), c = __builtin_amdgcn_readlane((int)v, 32), d = __builtin_amdgcn_readlane((int)v, 48);
  return max(max(a, b), max(c, d));
}
DI unsigned mkkey(float s, int idx) { unsigned u = __float_as_uint(s); u ^= (u >> 31) ? 0xffffffffu : 0x80000000u; return (u & ~0xffu) | (unsigned)(255 - idx); }
DI float keyval(unsigned k) { unsigned u = k & ~0xffu; u ^= (u >> 31) ? 0x80000000u : 0xffffffffu; return __uint_as_float(u); }
DI unsigned top16_keys2(unsigned k0, unsigned k1, int lane) {
  unsigned res = 0;
  for (int it = 0; it < 16; it++) {
    const unsigned m = wave_max_u(max(k0, k1));
    if (k0 == m) k0 = 0; if (k1 == m) k1 = 0;
    if (lane == it) res = m;
  }
  return res;
}
DI void topk_one(const float* __restrict__ s, int lane, int ci, int cj, bool cvalid, int& e_out, float& g_out) {
  const unsigned r1 = top16_keys2(mkkey(s[lane], lane), mkkey(s[64 + lane], 64 + lane), lane);
  const unsigned r2 = top16_keys2(mkkey(s[128 + lane], lane), mkkey(s[192 + lane], 64 + lane), lane);
  const float s1 = keyval(r1), s2 = keyval(r2);
  const int i1 = 255 - (int)(r1 & 0xffu), i2 = 255 - (int)(r2 & 0xffu);
  const float cand = __shfl(s1, ci) + __shfl(s2, cj);
  unsigned ck = cvalid ? mkkey(cand, lane) : 0u;
  unsigned rt = 0;
  for (int it = 0; it < 16; it++) {
    const unsigned m = wave_max_u(ck);
    if (ck == m) ck = 0;
    if (lane == it) rt = m;
  }
  const float tv = keyval(rt);
  const int cl = 255 - (int)(rt & 0xffu);
  const int wi = __shfl(ci, cl & 63), wj = __shfl(cj, cl & 63);
  const int e1 = __shfl(i1, wi), e2 = __shfl(i2, wj);
  const float mx = __shfl(tv, 0);
  const float ex = lane < 16 ? __expf(tv - mx) : 0.f;
  const float sum = wave_sum(ex);
  e_out = (e1 * 128 + e2) & 16383; g_out = ex / sum;
}

typedef float f2g __attribute__((ext_vector_type(2)));
struct GBuf { u32x4 u[2][2], v[2][2]; };
DI void phase_gather(const Params& p, int layer, char* lds) {
  const bf16_t* hm = (const bf16_t*)(p.ws + WS_HM);
  const unsigned char* ub = (const unsigned char*)(p.ws + WS_UB) + (size_t)layer * 16384 * 2048;
  const unsigned char* vb = (const unsigned char*)(p.ws + WS_VB) + (size_t)layer * 16384 * 2048;
  const float* usc = (const float*)(p.ws + WS_TSC) + layer * 16384;
  const float* vsc = (const float*)(p.ws + WS_TSC) + 32768 + layer * 16384;
  const float* sc = (const float*)(p.ws + WS_SC);
  const float* mod = (const float*)(p.ws + WS_MOD) + layer * 36864;
  float* xbuf = p.out; float* red = (float*)lds;
  const int tid = tid_(), lane = tid & 63, wave = tid >> 6;
  int ci = 0, cj = 0; bool cvalid = false;
  { int base = 0;
    for (int i = 0; i < 16; i++) { const int cnt = 16 / (i + 1); if (lane >= base && lane < base + cnt) { ci = i; cj = lane - base; cvalid = true; } base += cnt; } }
  const unsigned lo16 = (unsigned)lane * 16u;
  auto gl = [&](GBuf& b, int e_lanes, int g) {
#pragma unroll
    for (int jj = 0; jj < 2; jj++) {
      const unsigned e = (unsigned)__builtin_amdgcn_readlane(e_lanes, 2 * g + jj);
      const unsigned char* ur = ub + (size_t)e * 2048 + lo16; const unsigned char* vr = vb + (size_t)e * 2048 + lo16;
      b.u[jj][0] = *(const u32x4*)ur; b.u[jj][1] = *(const u32x4*)(ur + 1024);
      b.v[jj][0] = *(const u32x4*)vr; b.v[jj][1] = *(const u32x4*)(vr + 1024);
    }
  };
  int t = blockIdx.x;
  int e_l = 0; float g_l = 0.f;
  if (t < T) { topk_one(sc + ((size_t)t * 8 + wave) * 256, lane, ci, cj, cvalid, e_l, g_l); e_l = __shfl(e_l, lane & 15); g_l = __shfl(g_l, lane & 15); }
  GBuf A, B;
  if (t < T) gl(A, e_l, 0);
  for (; t < T; t += gridDim.x) {
    const int tn = t + gridDim.x < T ? t + gridDim.x : t;
    int e_n; float g_n;
    topk_one(sc + ((size_t)tn * 8 + wave) * 256, lane, ci, cj, cvalid, e_n, g_n); e_n = __shfl(e_n, lane & 15); g_n = __shfl(g_n, lane & 15);
    f2g x2[16];
#pragma unroll
    for (int hsel = 0; hsel < 2; hsel++)
#pragma unroll
      for (int c = 0; c < 2; c++) {
        const u32x4 u = *(const u32x4*)&hm[(size_t)t * 2048 + hsel * 1024 + lane * 16 + c * 8];
#pragma unroll
        for (int i = 0; i < 4; i++) x2[hsel * 8 + c * 4 + i] = f2g{lo2f(u[i]), hi2f(u[i])};
      }
    const float us_l = usc[e_l], vs_l = vsc[e_l];
    f2g acc2[16];
#pragma unroll
    for (int i = 0; i < 16; i++) acc2[i] = f2g{0.f, 0.f};
    auto comp = [&](GBuf& b, int g) {
      float coef[2];
#pragma unroll
      for (int jj = 0; jj < 2; jj++) {
        f2g d2 = {0.f, 0.f};
#pragma unroll
        for (int hsel = 0; hsel < 2; hsel++)
#pragma unroll
          for (int i = 0; i < 4; i++) {
            const f2g lo = __builtin_amdgcn_cvt_pk_f32_fp8((int)b.u[jj][hsel][i], false), hi = __builtin_amdgcn_cvt_pk_f32_fp8((int)b.u[jj][hsel][i], true);
            d2 = lo * x2[hsel * 8 + 2 * i] + d2; d2 = hi * x2[hsel * 8 + 2 * i + 1] + d2;
          }
        const float d = wave_sum(d2[0] + d2[1]) * rdlane(us_l, 2 * g + jj);
        coef[jj] = rdlane(g_l, 2 * g + jj) * rdlane(vs_l, 2 * g + jj) * 0.5f * d * (1.f + erff(d * 0.70710678118654752f));
      }
#pragma unroll
      for (int jj = 0; jj < 2; jj++) {
        const f2g c2 = {coef[jj], coef[jj]};
#pragma unroll
        for (int hsel = 0; hsel < 2; hsel++)
#pragma unroll
          for (int i = 0; i < 4; i++) {
            const f2g lo = __builtin_amdgcn_cvt_pk_f32_fp8((int)b.v[jj][hsel][i], false), hi = __builtin_amdgcn_cvt_pk_f32_fp8((int)b.v[jj][hsel][i], true);
            acc2[hsel * 8 + 2 * i] = c2 * lo + acc2[hsel * 8 + 2 * i]; acc2[hsel * 8 + 2 * i + 1] = c2 * hi + acc2[hsel * 8 + 2 * i + 1];
          }
      }
    };
#pragma unroll 1
    for (int g = 0; g < 8; g += 2) {
      gl(B, e_l, g + 1);
      __builtin_amdgcn_sched_barrier(0);
      comp(A, g);
      __builtin_amdgcn_sched_barrier(0);
      if (g + 2 < 8) gl(A, e_l, g + 2); else gl(A, e_n, 0);
      __builtin_amdgcn_sched_barrier(0);
      comp(B, g + 1);
      __builtin_amdgcn_sched_barrier(0);
    }
    e_l = e_n; g_l = g_n;
#pragma unroll
    for (int hsel = 0; hsel < 2; hsel++)
#pragma unroll
      for (int i = 0; i < 4; i++) {
        const float4 a4 = {acc2[hsel * 8 + 2 * i][0], acc2[hsel * 8 + 2 * i][1], acc2[hsel * 8 + 2 * i + 1][0], acc2[hsel * 8 + 2 * i + 1][1]};
        *(float4*)&red[wave * 2048 + hsel * 1024 + lane * 16 + i * 4] = a4;
      }
    __syncthreads();
    {
      const int n = tid * 4;
      float4 sm = *(float4*)&red[n];
#pragma unroll
      for (int w = 1; w < 8; w++) { const float4 a = *(float4*)&red[w * 2048 + n]; sm.x += a.x; sm.y += a.y; sm.z += a.z; sm.w += a.w; }
      const float4 gt = *(const float4*)&mod[cvec_of(t) * 12288 + 5 * 2048 + n];
      float4 xo = *(float4*)&xbuf[(size_t)t * 2048 + n];
      xo.x += gt.x * sm.x; xo.y += gt.y * sm.y; xo.z += gt.z * sm.z; xo.w += gt.w * sm.w;
      *(float4*)&xbuf[(size_t)t * 2048 + n] = xo;
      if (layer == 0) {
        const float ss = wave_sum(xo.x * xo.x + xo.y * xo.y + xo.z * xo.z + xo.w * xo.w);
        __syncthreads();
        if (lane == 0) red[wave] = ss;
        __syncthreads();
        float tot = 0.f;
#pragma unroll
        for (int w = 0; w < 8; w++) tot += red[w];
        const float rstd = rsqrtf(tot * (1.f / 2048.f) + 1e-6f);
        const float* m1 = (const float*)(p.ws + WS_MOD) + 36864 + cvec_of(t) * 12288;
        const float4 g = *(const float4*)&p.in[IN_NORM1][2048 + n], sc1 = *(const float4*)&m1[2048 + n], sh1 = *(const float4*)&m1[n];
        const u32x2 o = {pack2(xo.x * rstd * g.x * (1.f + sc1.x) + sh1.x, xo.y * rstd * g.y * (1.f + sc1.y) + sh1.y),
                         pack2(xo.z * rstd * g.z * (1.f + sc1.z) + sh1.z, xo.w * rstd * g.w * (1.f + sc1.w) + sh1.w)};
        *(u32x2*)((bf16_t*)(p.ws + WS_HM) + (size_t)t * 2048 + n) = o;
      }
    }
    __syncthreads();
  }
}

DI float2 cmul(float2 a, float2 b) { return make_float2(a.x * b.x - a.y * b.y, a.x * b.y + a.y * b.x); }
DI int PI(int p) { return p + ((p >> 5) << 3); }
DI float2 cadd(float2 a, float2 b) { return make_float2(a.x + b.x, a.y + b.y); }
DI float2 csub(float2 a, float2 b) { return make_float2(a.x - b.x, a.y - b.y); }
DI float2 cmulc(float2 a, float2 b) { return make_float2(a.x * b.x + a.y * b.y, a.y * b.x - a.x * b.y); }
typedef float c2 __attribute__((ext_vector_type(2)));
DI c2 cm(c2 a, c2 t, c2 ts) { return c2{a[0], a[0]} * t + c2{a[1], a[1]} * ts; }
DI void fft_dif(float2* buf_, const float2* tw_, int n) {
  c2* buf = (c2*)buf_; const c2* tw = (const c2*)tw_;
  const int tid = tid_();
  for (int h = n >> 1; h >= 4; h >>= 2) {
    const int q = h >> 1;
    if (q <= 512) {
      const int j = tid & (q - 1), base = ((tid - j) << 2) + j;
      const int a0 = PI(base), a1 = PI(base + q), a2 = PI(base + 2 * q), a3 = PI(base + 3 * q);
      const c2 t = tw[h + j], t2 = tw[q + j], ts = {-t[1], t[0]}, t2s = {-t2[1], t2[0]};
#pragma unroll
      for (int r = 0; r < 4; r++) {
        const int o = r * 2560;
        const c2 x0 = buf[a0 + o], x1 = buf[a1 + o], x2 = buf[a2 + o], x3 = buf[a3 + o];
        const c2 a02 = x0 + x2, s02 = x0 - x2, a13 = x1 + x3, s13 = x1 - x3;
        const c2 u2 = cm(s02, t, ts), m = cm(s13, t, ts), u3 = {m[1], -m[0]};
        buf[a0 + o] = a02 + a13; buf[a1 + o] = cm(a02 - a13, t2, t2s);
        buf[a2 + o] = u2 + u3;   buf[a3 + o] = cm(u2 - u3, t2, t2s);
      }
    } else {
#pragma unroll
      for (int r = 0; r < 4; r++) {
        const int i = tid + r * 512, j = i & (q - 1), base = ((i - j) << 2) + j;
        const int a0 = PI(base), a1 = PI(base + q), a2 = PI(base + 2 * q), a3 = PI(base + 3 * q);
        const c2 t = tw[h + j], t2 = tw[q + j], ts = {-t[1], t[0]}, t2s = {-t2[1], t2[0]};
        const c2 x0 = buf[a0], x1 = buf[a1], x2 = buf[a2], x3 = buf[a3];
        const c2 a02 = x0 + x2, s02 = x0 - x2, a13 = x1 + x3, s13 = x1 - x3;
        const c2 u2 = cm(s02, t, ts), m = cm(s13, t, ts), u3 = {m[1], -m[0]};
        buf[a0] = a02 + a13; buf[a1] = cm(a02 - a13, t2, t2s);
        buf[a2] = u2 + u3;   buf[a3] = cm(u2 - u3, t2, t2s);
      }
    }
    __syncthreads();
  }
#pragma unroll
  for (int r = 0; r < 8; r++) {
    const int a = PI(2 * (tid + r * 512));
    const float4 v = *(const float4*)&buf[a];
    *(float4*)&buf[a] = make_float4(v.x + v.z, v.y + v.w, v.x - v.z, v.y - v.w);
  }
  __syncthreads();
}
DI void fft_dit_inv(float2* buf_, const float2* tw_, int n) {
  c2* buf = (c2*)buf_; const c2* tw = (const c2*)tw_;
  const int tid = tid_();
#pragma unroll
  for (int r = 0; r < 8; r++) {
    const int a = PI(2 * (tid + r * 512));
    const float4 v = *(const float4*)&buf[a];
    *(float4*)&buf[a] = make_float4(v.x + v.z, v.y + v.w, v.x - v.z, v.y - v.w);
  }
  __syncthreads();
  for (int h = 4; h <= (n >> 1); h <<= 2) {
    const int q = h >> 1;
    if (q <= 512) {
      const int j = tid & (q - 1), base = ((tid - j) << 2) + j;
      const int a0 = PI(base), a1 = PI(base + q), a2 = PI(base + 2 * q), a3 = PI(base + 3 * q);
      const c2 tt = tw[h + j], tt2 = tw[q + j];
      const c2 t = {tt[0], -tt[1]}, ts = {tt[1], tt[0]}, t2 = {tt2[0], -tt2[1]}, t2s = {tt2[1], tt2[0]};
#pragma unroll
      for (int r = 0; r < 4; r++) {
        const int o = r * 2560;
        const c2 y0 = buf[a0 + o], y1 = buf[a1 + o], y2 = buf[a2 + o], y3 = buf[a3 + o];
        const c2 v1 = cm(y1, t2, t2s), v3 = cm(y3, t2, t2s);
        const c2 u0 = y0 + v1, u1 = y0 - v1, u2 = y2 + v3, u3 = y2 - v3;
        const c2 w2 = cm(u2, t, ts), m = cm(u3, t, ts), w3 = {-m[1], m[0]};
        buf[a0 + o] = u0 + w2; buf[a2 + o] = u0 - w2; buf[a1 + o] = u1 + w3; buf[a3 + o] = u1 - w3;
      }
    } else {
#pragma unroll
      for (int r = 0; r < 4; r++) {
        const int i = tid + r * 512, j = i & (q - 1), base = ((i - j) << 2) + j;
        const int a0 = PI(base), a1 = PI(base + q), a2 = PI(base + 2 * q), a3 = PI(base + 3 * q);
        const c2 tt = tw[h + j], tt2 = tw[q + j];
        const c2 t = {tt[0], -tt[1]}, ts = {tt[1], tt[0]}, t2 = {tt2[0], -tt2[1]}, t2s = {tt2[1], tt2[0]};
        const c2 y0 = buf[a0], y1 = buf[a1], y2 = buf[a2], y3 = buf[a3];
        const c2 v1 = cm(y1, t2, t2s), v3 = cm(y3, t2, t2s);
        const c2 u0 = y0 + v1, u1 = y0 - v1, u2 = y2 + v3, u3 = y2 - v3;
        const c2 w2 = cm(u2, t, ts), m = cm(u3, t, ts), w3 = {-m[1], m[0]};
        buf[a0] = u0 + w2; buf[a2] = u0 - w2; buf[a1] = u1 + w3; buf[a3] = u1 - w3;
      }
    }
    __syncthreads();
  }
}
DI float conv3_row(const bf16_t* __restrict__ row, int tl, int L, float w0, float w1, float w2, float b) {
  float v = bf2f(row[0]) * w1 + b;
  if (tl > 0) v += bf2f(row[-1]) * w0;
  if (tl < L - 1) v += bf2f(row[1]) * w2;
  return v;
}
template <int L>
DI void hyena_item(const Params& p, int c, float2* buf, const float2* tw, float* sred) {
  constexpr int N = 2 * L, NPOS = (L == 4096) ? 8 : 16;
  constexpr int NTAP = (L == 4096) ? 8 : 1;
  const int tid = tid_();
  const bool act = (L == 4096) ? true : (tid < 256);
  const bf16_t* ut = (const bf16_t*)(p.ws + WS_UT);
  bf16_t* z2t = (bf16_t*)(p.ws + WS_Z2T);
  const float* cw = p.in[IN_OC_CONV]; const float* cb = p.in[IN_OC_CONVB]; const float* bias = p.in[IN_OC_BIAS];
  float hf[2][2][NTAP];
  {
    const bf16_t* filt = (const bf16_t*)(p.ws + WS_FILT) + (L == 4096 ? 256 : 0);
    const float delta = fabsf(-3.0701134573253945f + (float)c * ((-15.350567286626973f + 3.0701134573253945f) / 2047.f));
    float ssq0 = 0.f, ssq1 = 0.f;
#pragma unroll
    for (int i = 0; i < NTAP; i++) {
      const int tt = tid + 512 * i;
      float a00 = 0.f, a01 = 0.f, a10 = 0.f, a11 = 0.f;
      if (tt < L) {
        const float dec = __expf(-((float)tt / (float)(L - 1)) * delta);
        a00 = bf2f(filt[(size_t)(0 * 2048 + c) * 4352 + tt]) * dec; a01 = bf2f(filt[(size_t)(1 * 2048 + c) * 4352 + tt]) * dec;
        a10 = bf2f(filt[(size_t)(2 * 2048 + c) * 4352 + tt]) * dec; a11 = bf2f(filt[(size_t)(3 * 2048 + c) * 4352 + tt]) * dec;
      }
      hf[0][0][i] = a00; hf[0][1][i] = a01; hf[1][0][i] = a10; hf[1][1][i] = a11;
      ssq0 += a00 * a00 + a01 * a01; ssq1 += a10 * a10 + a11 * a11;
    }
    __syncthreads();
    ssq0 = wave_sum(ssq0); ssq1 = wave_sum(ssq1);
    if ((tid & 63) == 0) { sred[(tid >> 6) * 2] = ssq0; sred[(tid >> 6) * 2 + 1] = ssq1; }
    __syncthreads();
    float t0 = 0.f, t1 = 0.f;
#pragma unroll
    for (int w = 0; w < 8; w++) { t0 += sred[w * 2]; t1 += sred[w * 2 + 1]; }
    const float sc0 = rsqrtf(t0 + 1e-12f), sc1 = rsqrtf(t1 + 1e-12f);
#pragma unroll
    for (int i = 0; i < NTAP; i++) { hf[0][0][i] *= sc0; hf[0][1][i] *= sc0; hf[1][0][i] *= sc1; hf[1][1][i] *= sc1; }
  }
  auto tok_of = [&](int i, int m) -> size_t {
    if (L == 4096) return (size_t)TP + (size_t)m * 4096 + tid + 512 * i;
    return (size_t)(2 * i + m) * 256 + tid;
  };
  auto tl_of = [&](int i) -> int { return (L == 4096) ? tid + 512 * i : tid; };
  float zin[NPOS][2];
  const float inv_n = 1.f / (float)N;
#pragma unroll
  for (int o = 0; o < 2; o++) {
    __syncthreads();
#pragma unroll
    for (int i = 0; i < NTAP; i++) {
      const int tt = tid + 512 * i;
      if (tt < L) {
        for (int seg = 0; seg < 8192 / N; seg++) {
          buf[PI(seg * N + tt)] = make_float2(hf[o][0][i], 0.f);
          if (tt >= 1) buf[PI(seg * N + N - tt)] = make_float2(hf[o][1][i], 0.f); else buf[PI(seg * N + L)] = make_float2(0.f, 0.f);
        }
      }
    }
    __syncthreads();
    fft_dif(buf, tw, N);
    float2 F[16];
#pragma unroll
    for (int i = 0; i < 16; i++) F[i] = buf[PI(tid + 512 * i)];
    __syncthreads();
    if (o == 0) {
      const float w0 = cw[4096 + c], w1 = cw[6144 + 4096 + c], w2 = cw[12288 + 4096 + c], bb = cb[4096 + c];
#pragma unroll
      for (int i = 0; i < NPOS; i++)
#pragma unroll
        for (int m = 0; m < 2; m++)
          zin[i][m] = act ? conv3_row(ut + (size_t)(4096 + c) * T + tok_of(i, m), tl_of(i), L, w0, w1, w2, bb) : 0.f;
    }
#pragma unroll
    for (int i = 0; i < 16; i++) {
      const int pp = tid + 512 * i;
      float2 val = make_float2(0.f, 0.f);
      if (L == 4096) { if (i < 8) val = make_float2(zin[i < 8 ? i : 0][0], zin[i < 8 ? i : 0][1]); }
      else { if (act) val = make_float2(zin[i % NPOS][0], zin[i % NPOS][1]); }
      buf[PI(pp)] = val;
    }
    __syncthreads();
    fft_dif(buf, tw, N);
#pragma unroll
    for (int i = 0; i < 16; i++) { const int pp = PI(tid + 512 * i); buf[pp] = cmul(buf[pp], F[i]); }
    __syncthreads();
    fft_dit_inv(buf, tw, N);
    {
      const int gcol = o * 2048 + c;
      const float w0 = cw[gcol], w1 = cw[6144 + gcol], w2 = cw[12288 + gcol], bb = cb[gcol];
      const float bo = bias[o * 2048 + c];
#pragma unroll
      for (int i = 0; i < NPOS; i++) {
        const int pp = (L == 4096) ? tid + 512 * i : i * 512 + tid;
        const float2 cv = buf[PI(pp)];
#pragma unroll
        for (int m = 0; m < 2; m++) {
          if (act) {
            const float gate = conv3_row(ut + (size_t)gcol * T + tok_of(i, m), tl_of(i), L, w0, w1, w2, bb);
            const float conv = (m == 0 ? cv.x : cv.y) * inv_n;
            zin[i][m] = gate * (conv + bo * zin[i][m]);
          }
        }
      }
    }
  }
  if (act) {
#pragma unroll
    for (int i = 0; i < NPOS; i++)
#pragma unroll
      for (int m = 0; m < 2; m++) z2t[(size_t)c * T + tok_of(i, m)] = f2bf(zin[i][m]);
  }
}
template <int L>
DI void hyena_item_mfma(const Params& p, int c, char* lds, float* sred) {
  constexpr int NTAP = (L == 4096) ? 8 : 1;
  constexpr int GN = 2 * L, GS = GN + 32, RS = 264;
  const int tid = tid_(), lane = tid & 63, wave = tid >> 6, r32 = lane & 31, h = lane >> 5;
  const size_t tokbase = (L == 4096) ? (size_t)TP : 0;
  bf16_t* G = (bf16_t*)lds;
  bf16_t* ub = (bf16_t*)(lds + 66560); bf16_t* zb = ub + 32 * RS; bf16_t* x1b = zb + 32 * RS; bf16_t* x2b = x1b + 32 * RS; bf16_t* zeros = x2b + 32 * RS;
  const bf16_t* ut = (const bf16_t*)(p.ws + WS_UT);
  bf16_t* z2t = (bf16_t*)(p.ws + WS_Z2T);
  const float* cw = p.in[IN_OC_CONV]; const float* cb = p.in[IN_OC_CONVB]; const float* bias = p.in[IN_OC_BIAS];
  float hf[2][2][NTAP];
  {
    const bf16_t* filt = (const bf16_t*)(p.ws + WS_FILT) + (L == 4096 ? 256 : 0);
    const float delta = fabsf(-3.0701134573253945f + (float)c * ((-15.350567286626973f + 3.0701134573253945f) / 2047.f));
    float ssq0 = 0.f, ssq1 = 0.f;
#pragma unroll
    for (int i = 0; i < NTAP; i++) {
      const int tt = tid + 512 * i;
      float a00 = 0.f, a01 = 0.f, a10 = 0.f, a11 = 0.f;
      if (tt < L) {
        const float dec = __expf(-((float)tt / (float)(L - 1)) * delta);
        a00 = bf2f(filt[(size_t)(0 * 2048 + c) * 4352 + tt]) * dec; a01 = bf2f(filt[(size_t)(1 * 2048 + c) * 4352 + tt]) * dec;
        a10 = bf2f(filt[(size_t)(2 * 2048 + c) * 4352 + tt]) * dec; a11 = bf2f(filt[(size_t)(3 * 2048 + c) * 4352 + tt]) * dec;
      }
      hf[0][0][i] = a00; hf[0][1][i] = a01; hf[1][0][i] = a10; hf[1][1][i] = a11;
      ssq0 += a00 * a00 + a01 * a01; ssq1 += a10 * a10 + a11 * a11;
    }
    __syncthreads();
    ssq0 = wave_sum(ssq0); ssq1 = wave_sum(ssq1);
    if (lane == 0) { sred[wave * 2] = ssq0; sred[wave * 2 + 1] = ssq1; }
    __syncthreads();
    float t0 = 0.f, t1 = 0.f;
#pragma unroll
    for (int w = 0; w < 8; w++) { t0 += sred[w * 2]; t1 += sred[w * 2 + 1]; }
    const float sc0 = rsqrtf(t0 + 1e-12f), sc1 = rsqrtf(t1 + 1e-12f);
#pragma unroll
    for (int i = 0; i < NTAP; i++) { hf[0][0][i] *= sc0; hf[0][1][i] *= sc0; hf[1][0][i] *= sc1; hf[1][1][i] *= sc1; }
  }
#pragma unroll
  for (int o = 0; o < 2; o++) {
    bf16_t* c0 = G + (o * 2 + 0) * GS; bf16_t* c1 = G + (o * 2 + 1) * GS;
#pragma unroll
    for (int i = 0; i < NTAP; i++) {
      const int tt = tid + 512 * i;
      if (tt < L) {
        const bf16_t f = f2bf(hf[o][0][i]), bw = f2bf(hf[o][1][i]);
        const int i_f = L - 1 - tt;
        c0[i_f] = f; if (i_f >= 1) c1[i_f - 1] = f;
        if (tt >= 1) { const int i_b = L - 1 + tt; c0[i_b] = bw; c1[i_b - 1] = bw; }
      }
    }
    if (tid == 0) { c0[2 * L - 1] = 0; c1[2 * L - 2] = 0; c1[2 * L - 1] = 0; }
  }
  if (tid < 128) ((unsigned*)zeros)[tid] = 0u;
  auto load_conv = [&](int rowsel, bf16_t* dst) {
    const bf16_t* src = ut + (size_t)rowsel * T + tokbase + 16 * tid;
    float f[18];
    unpack8(*(const u32x4*)src, f + 1); unpack8(*(const u32x4*)(src + 8), f + 9);
    const int pos = (16 * tid) & (L - 1);
    f[0] = pos > 0 ? bf2f(src[-1]) : 0.f; f[17] = pos + 16 < L ? bf2f(src[16]) : 0.f;
    const float w0 = cw[rowsel], w1 = cw[6144 + rowsel], w2 = cw[12288 + rowsel], bb = cb[rowsel];
    float o[16];
#pragma unroll
    for (int e = 0; e < 16; e++) o[e] = f[e] * w0 + f[e + 1] * w1 + f[e + 2] * w2 + bb;
    const u32x4 o0 = {pack2(o[0], o[1]), pack2(o[2], o[3]), pack2(o[4], o[5]), pack2(o[6], o[7])};
    const u32x4 o1 = {pack2(o[8], o[9]), pack2(o[10], o[11]), pack2(o[12], o[13]), pack2(o[14], o[15])};
    bf16_t* d = dst + (tid >> 4) * RS + (tid & 15) * 16;
    *(u32x4*)d = o0; *(u32x4*)(d + 8) = o1;
  };
  load_conv(4096 + c, ub); load_conv(c, x1b); load_conv(2048 + c, x2b);
  __syncthreads();
  auto conv = [&](int o, const bf16_t* bsrc) -> f32x16 {
    f32x16 acc;
#pragma unroll
    for (int r = 0; r < 16; r++) acc[r] = 0.f;
    const int par = (r32 & 1) ^ 1;
    const unsigned* gc = (const unsigned*)(G + (o * 2 + par) * GS);
    const int i00 = L - 1 - 32 * wave - r32 + 8 * h;
    u32x4 cur[16];
    auto loadB = [&]() {
#pragma unroll
      for (int kb = 0; kb < 16; kb++) cur[kb] = *(const u32x4*)(bsrc + r32 * RS + 8 * h + 16 * kb);
    };
    auto mm = [&](int m) {
      const unsigned* gp = gc + ((i00 - 256 * m - par) >> 1);
#pragma unroll
      for (int kb = 0; kb < 16; kb++) {
        const u32x4 av = {gp[8 * kb], gp[8 * kb + 1], gp[8 * kb + 2], gp[8 * kb + 3]};
        acc = __builtin_amdgcn_mfma_f32_32x32x16_bf16(__builtin_bit_cast(bf16x8, av), __builtin_bit_cast(bf16x8, cur[kb]), acc, 0, 0, 0);
      }
    };
    loadB(); mm(0);
    if constexpr (L == 4096) {
#pragma unroll 1
      for (int m = 1; m <= 15; m++) {
#pragma unroll
        for (int kb = 0; kb < 16; kb++)
#pragma unroll
          for (int e = 0; e < 4; e++) cur[kb][e] = (unsigned)__builtin_amdgcn_update_dpp(0, (int)cur[kb][e], 0x111, 0xf, 0xf, true);
        mm(m);
      }
      loadB();
#pragma unroll 1
      for (int m = -1; m >= -15; m--) {
#pragma unroll
        for (int kb = 0; kb < 16; kb++)
#pragma unroll
          for (int e = 0; e < 4; e++) cur[kb][e] = (unsigned)__builtin_amdgcn_update_dpp(0, (int)cur[kb][e], 0x101, 0xf, 0xf, true);
        mm(m);
      }
    }
    return acc;
  };
  auto gate = [&](const f32x16& acc, const bf16_t* uin, const bf16_t* gt, float bo, bf16_t* dst) {
#pragma unroll
    for (int k = 0; k < 4; k++) {
      const int idx = r32 * RS + 32 * wave + 8 * k + 4 * h;
      const u32x2 uu = *(const u32x2*)(uin + idx), gg = *(const u32x2*)(gt + idx);
      const float u0 = lo2f(uu[0]), u1 = hi2f(uu[0]), u2 = lo2f(uu[1]), u3 = hi2f(uu[1]);
      const float g0 = lo2f(gg[0]), g1 = hi2f(gg[0]), g2 = lo2f(gg[1]), g3 = hi2f(gg[1]);
      const u32x2 ov = {pack2(g0 * (acc[4 * k] + bo * u0), g1 * (acc[4 * k + 1] + bo * u1)), pack2(g2 * (acc[4 * k + 2] + bo * u2), g3 * (acc[4 * k + 3] + bo * u3))};
      *(u32x2*)(dst + idx) = ov;
    }
  };
  { const f32x16 a0 = conv(0, ub); gate(a0, ub, x1b, bias[c], zb); }
  __syncthreads();
  { const f32x16 a1 = conv(1, zb); gate(a1, zb, x2b, bias[2048 + c], ub); }
  __syncthreads();
  { bf16_t* dstp = z2t + (size_t)c * T + tokbase + 16 * tid;
    const bf16_t* sp = ub + (tid >> 4) * RS + (tid & 15) * 16;
    *(u32x4*)dstp = *(const u32x4*)sp; *(u32x4*)(dstp + 8) = *(const u32x4*)(sp + 8); }
}
DI void phase_hyena_mfma(const Params& p, char* lds) {
  __shared__ float sred_m[32];
  for (int it = blockIdx.x; it < 4096; it += gridDim.x) {
    if (it < 2048) hyena_item_mfma<4096>(p, it, lds, sred_m);
    else hyena_item_mfma<256>(p, it - 2048, lds, sred_m);
  }
}
DI void phase_hyena(const Params& p, char* lds) {
  float2* buf = (float2*)lds; float2* tw = (float2*)(lds + 81920);
  __shared__ float sred_s[32 + 256];
  for (int k = tid_(); k < 8192; k += NTH) {
    if (k >= 1) { const int half = 1 << (31 - __clz(k)); float s, c; sincospif((float)(k - half) / (float)half, &s, &c); tw[k] = make_float2(c, -s); }
  }
  __syncthreads();
  for (int it = blockIdx.x; it < 4096; it += gridDim.x) {
    if (it < 2048) hyena_item<4096>(p, it, buf, tw, sred_s);
    else hyena_item<256>(p, it - 2048, buf, tw, sred_s);
  }
}
DI void phase_transpose_z2(const Params& p, char* lds) {
  const bf16_t* src = (const bf16_t*)(p.ws + WS_Z2T); bf16_t* dst = (bf16_t*)(p.ws + WS_HM);
  bf16_t* tile = (bf16_t*)lds;
  const int tid = tid_();
  for (int tI = blockIdx.x; tI < 32 * 256; tI += gridDim.x) {
    const int c0 = (tI >> 8) * 64, t0 = (tI & 255) * 64;
    { const int r = tid >> 3, ch = tid & 7;
      *(u32x4*)&tile[r * 72 + ch * 8] = *(const u32x4*)&src[(size_t)(c0 + r) * T + t0 + ch * 8]; }
    __syncthreads();
    { const int tt = tid >> 3, cc = tid & 7;
      unsigned short v[8];
#pragma unroll
      for (int j = 0; j < 8; j++) v[j] = tile[(cc * 8 + j) * 72 + tt];
      u32x4 o = {(unsigned)v[0] | ((unsigned)v[1] << 16), (unsigned)v[2] | ((unsigned)v[3] << 16), (unsigned)v[4] | ((unsigned)v[5] << 16), (unsigned)v[6] | ((unsigned)v[7] << 16)};
      *(u32x4*)&dst[(size_t)(t0 + tt) * 2048 + c0 + cc * 8] = o; }
    __syncthreads();
  }
}

DI void peer_block(const Params& p, int layer, const XcdBarrier& xb, char* lds) {
  const float* mod = (const float*)(p.ws + WS_MOD) + layer * 36864;
  bf16_t* hm = (bf16_t*)(p.ws + WS_HM);
  phase_norm(p.out, p.out + (size_t)TP * 2048, p.in[IN_NORM2] + layer * 2048, mod, 3 * 2048, 4 * 2048, hm);
  xcd_barrier(xb);
  { EpiBF16 e{(bf16_t*)(p.ws + WS_PQ), 2048};
    gemm_full<256>(hm, 2048, (const bf16_t*)(p.ws + WS_WT_Q) + (size_t)layer * 2048 * 2048, 2048, T, 2048, 2048, e, lds); }
  xcd_barrier(xb);
  {
    EpiF32 e{(float*)(p.ws + WS_SC), 2048};
    const bf16_t* q = (const bf16_t*)(p.ws + WS_PQ); const bf16_t* keys = (const bf16_t*)(p.ws + WS_KEYS) + (size_t)layer * 2048 * 128;
    for (int tile = blockIdx.x; tile < 64 * 16; tile += gridDim.x) {
      const int g = tile & 15, mt = tile >> 4;
      gemm_tile<128>(q + g * 128, 2048, keys, 128, mt * 256, g * 128, 2048, 128, e, lds);
    }
  }
  xcd_barrier(xb);
  phase_gather(p, layer, lds);
  xcd_barrier(xb);
}

__global__ void __launch_bounds__(NTH) fwd_megakernel(Params p) {
  cg::grid_group grid = cg::this_grid();
  __shared__ __attribute__((aligned(16))) char lds[LDS_BYTES];
  float* mod = (float*)(p.ws + WS_MOD);
  bf16_t* hm = (bf16_t*)(p.ws + WS_HM);

  __shared__ uint4 xb_words;
  unsigned* bar = (unsigned*)(p.ws + WS_BAR);
  if (tid_() == 0) xb_words = make_uint4(0u, 0u, 0u, 0u);
  if (blockIdx.x == 0) for (int i = tid_(); i < XCD_BAR_WORDS; i += NTH) bar[i] = 0u;
  transpose_tiles(p.in[IN_EW_IN], (bf16_t*)(p.ws + WS_WT_IN0), 2048, ZC, (float*)lds);
  for (int d = 0; d < 2; d++) {
    transpose_tiles(p.in[IN_EA_WU] + d * 65536, (bf16_t*)(p.ws + WS_WU_T) + d * 65536, 64, 1024, (float*)lds);
    transpose_tiles(p.in[IN_EA_AU] + d * 65536, (bf16_t*)(p.ws + WS_AU_T) + d * 65536, 64, 1024, (float*)lds);
  }
  transpose_tiles(p.in[IN_EA_GU], (bf16_t*)(p.ws + WS_GU_T), 128, 1024, (float*)lds);
  convert_bf16(p.in[IN_PEER_KEYS], (bf16_t*)(p.ws + WS_KEYS), (size_t)2 * 2048 * 128 / 8);
  phase_mod_partial(p);
  phase_hdn2(p);
  grid.sync();
  const XcdBarrier xb = xcd_barrier_post(bar, (volatile LAS unsigned*)&xb_words);
  phase_mod_reduce(p);
  xcd_barrier(xb);
  phase_norm(p.in[IN_X_PROMPT], p.in[IN_X_SAMPLE], p.in[IN_NORM1], mod, 0, 2048, hm);
  xcd_barrier(xb);
  { EpiBF16 e{(bf16_t*)(p.ws + WS_Z0), ZC};
    gemm_full<256>(hm, 2048, (const bf16_t*)(p.ws + WS_WT_IN0), 2048, T, ZC, 2048, e, lds); }
  xcd_barrier(xb);
  phase_prep0(p, lds);
  xcd_barrier(xb);
  {
    const bf16_t* Qb = (const bf16_t*)(p.ws + WS_QB); bf16_t* A2 = (bf16_t*)(p.ws + WS_A2);
    for (int it = blockIdx.x; it < 512; it += gridDim.x) {
      __syncthreads();
      size_t row0, kvoff; int h, seq; const bf16_t *Kb, *Vb;
      if (it < 256) {
        const int b = it >> 7, qb = it & 15; h = (it >> 4) & 7;
        row0 = (size_t)TP + (size_t)b * 4096 + qb * 256; kvoff = (size_t)b * SKV_S * 256; seq = SKV_S;
        Kb = (const bf16_t*)(p.ws + WS_KBS); Vb = (const bf16_t*)(p.ws + WS_VBS);
      } else {
        const int i = it - 256, b = i >> 3; h = i & 7;
        row0 = (size_t)b * 256; kvoff = row0 * 256; seq = 256;
        Kb = (const bf16_t*)(p.ws + WS_KBP); Vb = (const bf16_t*)(p.ws + WS_VBP);
      }
      attn_dense_body<1024, 256, 2048>(Qb + row0 * 1024 + h * 128, Kb + kvoff + (h >> 2) * 128, Vb + kvoff + (h >> 2) * 128,
                                       A2 + row0 * 2048 + 1024 + h * 128, seq, lds);
    }
    __syncthreads();
    const bf16_t* actA = (const bf16_t*)(p.ws + WS_ACTA);
    for (int d = 0; d < 2; d++) {
      EpiW ew{(float*)(p.ws + WS_W), p.in[IN_EA_W0], d};
      gemm_full<256>(actA + d * 64, 384, (const bf16_t*)(p.ws + WS_WU_T) + d * 65536, 64, T, 1024, 64, ew, lds);
      EpiA ea{(float*)(p.ws + WS_KKA), p.in[IN_EA_A0], d};
      gemm_full<256>(actA + 128 + d * 64, 384, (const bf16_t*)(p.ws + WS_AU_T) + d * 65536, 64, T, 1024, 64, ea, lds);
    }
    EpiF32 eg{(float*)(p.ws + WS_G), 1024};
    gemm_full<256>(actA + 256, 384, (const bf16_t*)(p.ws + WS_GU_T), 128, T, 1024, 128, eg, lds);
  }
  xcd_barrier(xb);
  phase_fixa(p);
  xcd_barrier(xb);
  phase_scan(p, lds);
  xcd_barrier(xb);
  phase_post0(p);
  xcd_barrier(xb);
  { EpiRes e{p.in[IN_X_PROMPT], p.in[IN_X_SAMPLE], mod + 2 * 2048, p.out};
    gemm_full<256>((const bf16_t*)(p.ws + WS_A2), 2048, (const bf16_t*)(p.ws + WS_WT_OUT0), 2048, T, 2048, 2048, e, lds); }
  xcd_barrier(xb);
  peer_block(p, 0, xb, lds);
  { EpiBF16 e{(bf16_t*)(p.ws + WS_UT), (size_t)T};
    gemm_full<256>((const bf16_t*)(p.ws + WS_WT_IN1), 2048, hm, 2048, 6144, T, 2048, e, lds); }
  { EpiBF16 e{(bf16_t*)(p.ws + WS_FILT), 4352};
    gemm_full<256>((const bf16_t*)(p.ws + WS_FW3T), 64, (const bf16_t*)(p.ws + WS_HDN2B), 64, 8192, 4352, 64, e, lds); }
  xcd_barrier(xb);
  phase_hyena_mfma(p, lds);
  xcd_barrier(xb);
  phase_transpose_z2(p, lds);
  xcd_barrier(xb);
  { EpiRes e{p.out, p.out + (size_t)TP * 2048, mod + 36864 + 2 * 2048, p.out};
    gemm_full<256>(hm, 2048, (const bf16_t*)(p.ws + WS_WT_OUT1), 2048, T, 2048, 2048, e, lds); }
  xcd_barrier(xb);
  peer_block(p, 1, xb, lds);
}

extern "C" void kernel_launch(void* const* d_in, const int* in_sizes, int n_in, void* d_out, int out_size, void* d_ws, size_t ws_size, hipStream_t stream) {
  static int grid_blocks = 0;
  if (!grid_blocks) {
    int dev = 0, cus = 0, per_cu = 0;
    hipGetDevice(&dev);
    hipDeviceGetAttribute(&cus, hipDeviceAttributeMultiprocessorCount, dev);
    hipOccupancyMaxActiveBlocksPerMultiprocessor(&per_cu, fwd_megakernel, NTH, 0);
    if (per_cu < 1) per_cu = 1;
    if (per_cu > 1) per_cu = 1;
    grid_blocks = cus * per_cu;
  }
  if (n_in != N_IN || ws_size < WS_END2) { fprintf(stderr, "kernel_launch: bad n_in %d or ws_size %zu < %zu\n", n_in, ws_size, (size_t)WS_END); return; }
  Params p{};
  for (int i = 0; i < N_IN; i++) p.in[i] = (const float*)d_in[i];
  p.out = (float*)d_out; p.ws = (char*)d_ws;
  void* args[] = {&p};
  hipError_t e = hipLaunchCooperativeKernel((void*)fwd_megakernel, dim3(grid_blocks), dim3(NTH), args, 0, stream);
  if (e != hipSuccess) fprintf(stderr, "cooperative launch failed: %s (grid %d)\n", hipGetErrorString(e), grid_blocks);
}
```

```cpp
#include <hip/hip_runtime.h>
#include <hip/hip_cooperative_groups.h>
#include <stdint.h>
#include <stdio.h>
namespace cg = cooperative_groups;

#define DI __device__ __forceinline__
typedef unsigned short bf16_t;
using bf16x8 = __attribute__((ext_vector_type(8))) short;
using s16x4  = __attribute__((ext_vector_type(4))) short;
using f32x16 = __attribute__((ext_vector_type(16))) float;
using u32x4  = __attribute__((ext_vector_type(4))) unsigned;
using u32x2  = __attribute__((ext_vector_type(2))) unsigned;

constexpr int NTH = 512;
constexpr int T = 16384, TP = 8192, DM = 2048;
constexpr int ZC = 4992;
constexpr int SKV_S = 4608;

enum { IN_X_PROMPT = 0, IN_X_SAMPLE, IN_CACHE_K, IN_CACHE_V, IN_STATE_A, IN_C, IN_C_CTX, IN_MOD_W, IN_MOD_B, IN_NORM1, IN_NORM2,
       IN_EW_IN, IN_EA_CONV, IN_EA_W0, IN_EA_WU, IN_EA_A0, IN_EA_AU, IN_EA_GU, IN_EA_KK, IN_EA_KA, IN_EA_RK, IN_EA_LNW, IN_EA_LNB,
       IN_EB_QN, IN_EB_KN, IN_EW_OUT,
       IN_OW_IN, IN_OC_CONV, IN_OC_CONVB, IN_OC_FW1, IN_OC_FB1, IN_OC_FREQ, IN_OC_FW2, IN_OC_FB2, IN_OC_FW3, IN_OC_BIAS, IN_OW_OUT,
       IN_PEER_WQ, IN_PEER_KEYS, IN_PEER_U, IN_PEER_V, N_IN };

struct Params { const float* in[N_IN]; float* out; char* ws; };

constexpr size_t OUT_Y = 0, OUT_NK = 33554432, OUT_NV = 35651584, OUT_NS = 37748736;

constexpr size_t al256(size_t x) { return (x + 255) / 256 * 256; }
constexpr size_t WS_WT_IN0  = 0;
constexpr size_t WS_WT_OUT0 = WS_WT_IN0 + (size_t)ZC * 2048 * 2;
constexpr size_t WS_WT_IN1  = WS_WT_OUT0 + (size_t)2048 * 2048 * 2;
constexpr size_t WS_WT_OUT1 = WS_WT_IN1 + (size_t)6144 * 2048 * 2;
constexpr size_t WS_WT_Q    = WS_WT_OUT1 + (size_t)2048 * 2048 * 2;
constexpr size_t WS_KEYS    = WS_WT_Q + (size_t)2 * 2048 * 2048 * 2;
constexpr size_t WS_WU_T    = WS_KEYS + (size_t)2 * 2048 * 128 * 2;
constexpr size_t WS_AU_T    = WS_WU_T + 262144;
constexpr size_t WS_GU_T    = WS_AU_T + 262144;
constexpr size_t WS_MPART   = WS_GU_T + 262144;
constexpr size_t WS_MOD     = WS_MPART + (size_t)2 * 64 * 3 * 12288 * 4;
constexpr size_t WS_HDN2    = WS_MOD + (size_t)2 * 3 * 12288 * 4;
constexpr size_t WS_FW3T    = al256(WS_HDN2 + (size_t)4352 * 64 * 4);
constexpr size_t WS_HDN2B   = WS_FW3T + (size_t)8192 * 64 * 2;
constexpr size_t WS_BAR     = al256(WS_HDN2B + (size_t)4352 * 64 * 2);
constexpr size_t WS_HM      = al256(WS_BAR + 16384);
constexpr size_t WS_Z0      = WS_HM + (size_t)T * 2048 * 2;
constexpr size_t WS_QB      = WS_Z0 + (size_t)T * ZC * 2;
constexpr size_t WS_KBP     = WS_QB + (size_t)T * 1024 * 2;
constexpr size_t WS_VBP     = WS_KBP + (size_t)8192 * 256 * 2;
constexpr size_t WS_KBS     = WS_VBP + (size_t)8192 * 256 * 2;
constexpr size_t WS_VBS     = WS_KBS + (size_t)2 * SKV_S * 256 * 2;
constexpr size_t WS_ACTA    = WS_VBS + (size_t)2 * SKV_S * 256 * 2;
constexpr size_t WS_BON     = WS_ACTA + (size_t)T * 384 * 2;
constexpr size_t WS_RW      = WS_BON + (size_t)T * 16 * 4;
constexpr size_t WS_R       = WS_RW;
constexpr size_t WS_KK      = WS_R + (size_t)T * 1024 * 4;
constexpr size_t WS_V       = WS_KK + (size_t)T * 1024 * 4;
constexpr size_t WS_W       = WS_V + (size_t)T * 1024 * 4;
constexpr size_t WS_KKA     = WS_W + (size_t)T * 2048 * 4;
constexpr size_t WS_KT      = WS_KKA + (size_t)T * 2048 * 4;
constexpr size_t WS_END     = WS_KT + (size_t)T * 2048 * 4;
constexpr size_t WS_G       = WS_Z0;
constexpr size_t WS_A2      = WS_Z0 + (size_t)T * 1024 * 4;
static_assert(WS_A2 + (size_t)T * 2048 * 2 <= WS_QB, "overlay");
constexpr size_t WS_UB      = WS_END;
constexpr size_t WS_END2    = WS_UB + (size_t)2 * 16384 * 2048;
constexpr size_t WS_VB      = WS_Z0 + (size_t)T * 1024 * 4 + (size_t)T * 2048 * 2;
static_assert(WS_VB + (size_t)2 * 16384 * 2048 <= WS_BON, "v tables overlay");
constexpr size_t WS_SC      = WS_RW;
constexpr size_t WS_UT      = WS_SC;
constexpr size_t WS_IDX     = WS_SC + (size_t)6144 * T * 2;
constexpr size_t WS_GATE    = WS_IDX + (size_t)T * 128 * 4;
constexpr size_t WS_FILT    = WS_GATE + (size_t)T * 128 * 4;
static_assert(WS_FILT + (size_t)8192 * 4352 * 2 <= WS_END, "overlay2");
constexpr size_t WS_TSC     = WS_MPART;
constexpr size_t WS_PQ      = WS_Z0;
constexpr size_t WS_Z2T     = WS_Z0;
static_assert(WS_END2 <= (size_t)1024 * 1024 * 1024, "ws budget");

constexpr int LDS_BYTES = 147456;

DI int tid_() { int t = __builtin_amdgcn_workitem_id_x(); asm volatile("" : "+v"(t)); return t; }
DI float bf2f(bf16_t b) { return __uint_as_float(((unsigned)b) << 16); }
DI bf16_t f2bf(float x) { unsigned u = __float_as_uint(x); u += 0x7fffu + ((u >> 16) & 1u); return (bf16_t)(u >> 16); }
DI unsigned pack2(float lo, float hi) { return (unsigned)f2bf(lo) | ((unsigned)f2bf(hi) << 16); }
DI float lo2f(unsigned u) { return __uint_as_float(u << 16); }
DI float hi2f(unsigned u) { return __uint_as_float(u & 0xffff0000u); }
DI int crow(int r, int h) { return (r & 3) + 8 * (r >> 2) + 4 * h; }
template <int CTRL> DI float dppf(float x) { return __int_as_float(__builtin_amdgcn_update_dpp(0, __float_as_int(x), CTRL, 0xf, 0xf, false)); }
DI float rdlane(float v, int l) { return __int_as_float(__builtin_amdgcn_readlane(__float_as_int(v), l)); }
DI float wave_sum(float v) {
  v += dppf<0xB1>(v); v += dppf<0x4E>(v); v += dppf<0x141>(v); v += dppf<0x140>(v);
  return (rdlane(v, 0) + rdlane(v, 16)) + (rdlane(v, 32) + rdlane(v, 48));
}
DI float wave_max(float v) {
  v = fmaxf(v, dppf<0xB1>(v)); v = fmaxf(v, dppf<0x4E>(v)); v = fmaxf(v, dppf<0x141>(v)); v = fmaxf(v, dppf<0x140>(v));
  return fmaxf(fmaxf(rdlane(v, 0), rdlane(v, 16)), fmaxf(rdlane(v, 32), rdlane(v, 48)));
}
DI float sigmoidf_(float x) { return __builtin_amdgcn_rcpf(1.f + __expf(-x)); }
DI int cvec_of(int t) { return t < TP ? 0 : 1 + ((t - TP) >> 12); }
template <int LPR> DI float row_reduce(float x) {
  x += dppf<0xB1>(x);
  x += dppf<0x4E>(x);
  if (LPR == 8) { x += dppf<0x141>(x); }
  if (LPR == 16) { x += dppf<0x124>(x); x += dppf<0x128>(x); }
  return x;
}
DI void unpack8(u32x4 u, float* f) {
  f[0] = lo2f(u[0]); f[1] = hi2f(u[0]); f[2] = lo2f(u[1]); f[3] = hi2f(u[1]);
  f[4] = lo2f(u[2]); f[5] = hi2f(u[2]); f[6] = lo2f(u[3]); f[7] = hi2f(u[3]);
}

#define XB_TMO      128
#define XB_XCNT(j)  (256  + 64 * (j))
#define XB_XSUB(j)  (1280 + 64 * (j))
#define XB_XGEN(j)  (2304 + 64 * (j))
#define XB_TOP      3328
#define XB_TOPGEN   3392
#define XCD_BAR_WORDS 3456
#define XB_SPIN_CAP (1u << 18)
#define LAS __attribute__((address_space(3)))
DI unsigned xb_ld(unsigned* p)              { return __hip_atomic_load(p, __ATOMIC_RELAXED, __HIP_MEMORY_SCOPE_AGENT); }
DI unsigned xb_add(unsigned* p, unsigned v) { return __hip_atomic_fetch_add(p, v, __ATOMIC_RELAXED, __HIP_MEMORY_SCOPE_AGENT); }
DI unsigned xb_xcc_id() { return (unsigned)__builtin_amdgcn_s_getreg((3 << 11) | 20) & 0xFu; }
#define XB_SPIN(cond, bar) do { unsigned _sp = 0; while (cond) { __builtin_amdgcn_s_sleep(1); \
    if ((++_sp & 255u) == 0u) { if (xb_ld(&(bar)[XB_TMO])) break; if (_sp > XB_SPIN_CAP) { atomicAdd(&(bar)[XB_TMO], 1u); break; } } } } while (0)
struct XcdBarrier { unsigned* bar; unsigned x; volatile LAS unsigned* st; };
DI XcdBarrier xcd_barrier_post(unsigned* bar, volatile LAS unsigned* st) {
  XcdBarrier b; b.bar = bar; b.x = xb_xcc_id(); b.st = st;
  if (__builtin_amdgcn_workitem_id_x() == 0) (void)xb_add(&bar[XB_XCNT(b.x)], 1u);
  return b;
}
DI void xcd_barrier_complete(unsigned* bar, unsigned x, unsigned& nloc, unsigned& nx) {
  const unsigned G = gridDim.x * gridDim.y * gridDim.z;
  unsigned sum, cnt, mine, sp = 0u;
  for (;;) {
    sum = 0u; cnt = 0u; mine = 0u;
#pragma unroll
    for (unsigned j = 0; j < 16; ++j) { const unsigned c = xb_ld(&bar[XB_XCNT(j)]); sum += c; cnt += (c > 0u) ? 1u : 0u; mine = (j == x) ? c : mine; }
    if (sum == G) break;
    __builtin_amdgcn_s_sleep(1);
    if ((++sp & 255u) == 0u) { if (xb_ld(&bar[XB_TMO])) break; if (sp > XB_SPIN_CAP) { atomicAdd(&bar[XB_TMO], 1u); break; } }
  }
  nloc = mine > 0u ? mine : 1u; nx = cnt > 0u ? cnt : 1u;
}
DI void xcd_barrier(const XcdBarrier& b) {
  asm volatile("s_waitcnt vmcnt(0)" ::: "memory");
  __syncthreads();
  if (__builtin_amdgcn_workitem_id_x() == 0) {
    unsigned* bar = b.bar;
    __builtin_amdgcn_s_waitcnt(0);
    unsigned nloc = b.st[0], nx = b.st[1];
    if (nloc == 0u) { xcd_barrier_complete(bar, b.x, nloc, nx); b.st[0] = nloc; b.st[1] = nx; }
    const unsigned old = xb_add(&bar[XB_XSUB(b.x)], 1u);
    const unsigned gen = old / nloc;
    if (old + 1u == (gen + 1u) * nloc) {
      __builtin_amdgcn_fence(__ATOMIC_RELEASE, "agent");
      asm volatile("s_waitcnt vmcnt(0)" ::: "memory");
      const unsigned og = xb_add(&bar[XB_TOP], 1u);
      const unsigned tg = og / nx;
      if (og + 1u == (tg + 1u) * nx) xb_add(&bar[XB_TOPGEN], 1u);
      else XB_SPIN(xb_ld(&bar[XB_TOPGEN]) == tg, bar);
      __builtin_amdgcn_fence(__ATOMIC_ACQUIRE, "agent");
      xb_add(&bar[XB_XGEN(b.x)], 1u);
      asm volatile("s_waitcnt vmcnt(0)" ::: "memory");
    } else {
      XB_SPIN(xb_ld(&bar[XB_XGEN(b.x)]) == gen, bar);
      __builtin_amdgcn_fence(__ATOMIC_ACQUIRE, "agent");
      asm volatile("s_waitcnt vmcnt(0)" ::: "memory");
    }
  }
  __syncthreads();
}

DI void transpose_tiles(const float* __restrict__ W, bf16_t* __restrict__ Wt, int K, int N, float* lds) {
  const int tn = N / 64, ntile = (K / 64) * tn, tid = tid_();
  for (int tile = blockIdx.x; tile < ntile; tile += gridDim.x) {
    const int k0 = (tile / tn) * 64, n0 = (tile % tn) * 64;
    const int r = tid >> 4, c4 = tid & 15;
#pragma unroll
    for (int i = 0; i < 2; i++) {
      float4 v = *(const float4*)&W[(size_t)(k0 + r + 32 * i) * N + n0 + c4 * 4];
      float* d = &lds[(r + 32 * i) * 65 + c4 * 4]; d[0] = v.x; d[1] = v.y; d[2] = v.z; d[3] = v.w;
    }
    __syncthreads();
    const int n = tid >> 3, kc = tid & 7;
    u32x4 o;
#pragma unroll
    for (int j = 0; j < 4; j++) o[j] = pack2(lds[(kc * 8 + 2 * j) * 65 + n], lds[(kc * 8 + 2 * j + 1) * 65 + n]);
    *(u32x4*)&Wt[(size_t)(n0 + n) * K + k0 + kc * 8] = o;
    __syncthreads();
  }
}
DI void convert_bf16(const float* __restrict__ src, bf16_t* __restrict__ dst, size_t n8) {
  for (size_t i = (size_t)blockIdx.x * NTH + tid_(); i < n8; i += (size_t)gridDim.x * NTH) {
    float4 a = *(const float4*)&src[i * 8], b = *(const float4*)&src[i * 8 + 4];
    u32x4 o = {pack2(a.x, a.y), pack2(a.z, a.w), pack2(b.x, b.y), pack2(b.z, b.w)};
    *(u32x4*)&dst[i * 8] = o;
  }
}

DI void convert_fp8_rows(const float* __restrict__ src, unsigned char* __restrict__ dst, float* __restrict__ invs, int rows) {
  const int lane = tid_() & 63, wave = tid_() >> 6;
  for (int r = blockIdx.x * 8 + wave; r < rows; r += gridDim.x * 8) {
    const float* x = src + (size_t)r * 2048;
    float4 v[8]; float mx = 0.f;
#pragma unroll
    for (int hsel = 0; hsel < 2; hsel++)
#pragma unroll
      for (int i = 0; i < 4; i++) {
        v[hsel * 4 + i] = *(const float4*)&x[hsel * 1024 + lane * 16 + i * 4];
        const float4 a = v[hsel * 4 + i];
        mx = fmaxf(mx, fmaxf(fmaxf(fabsf(a.x), fabsf(a.y)), fmaxf(fabsf(a.z), fabsf(a.w))));
      }
    mx = fmaxf(wave_max(mx), 1e-30f);
    const float sc = 224.f / mx;
    if (lane == 0) invs[r] = mx * (1.f / 224.f);
#pragma unroll
    for (int hsel = 0; hsel < 2; hsel++) {
      u32x4 o;
#pragma unroll
      for (int i = 0; i < 4; i++) {
        const float4 a = v[hsel * 4 + i];
        int w = __builtin_amdgcn_cvt_pk_fp8_f32(a.x * sc, a.y * sc, 0, false);
        w = __builtin_amdgcn_cvt_pk_fp8_f32(a.z * sc, a.w * sc, w, true);
        o[i] = (unsigned)w;
      }
      *(u32x4*)&dst[(size_t)r * 2048 + hsel * 1024 + lane * 16] = o;
    }
  }
}
DI void convert_fp8_rows_w(const float* __restrict__ src, unsigned char* __restrict__ dst, float* __restrict__ invs, int rows, int widx, int nw) {
  const int lane = tid_() & 63;
  for (int r = widx; r < rows; r += nw) {
    const float* x = src + (size_t)r * 2048;
    float4 v[8]; float mx = 0.f;
#pragma unroll
    for (int hsel = 0; hsel < 2; hsel++)
#pragma unroll
      for (int i = 0; i < 4; i++) {
        v[hsel * 4 + i] = *(const float4*)&x[hsel * 1024 + lane * 16 + i * 4];
        const float4 a = v[hsel * 4 + i];
        mx = fmaxf(mx, fmaxf(fmaxf(fabsf(a.x), fabsf(a.y)), fmaxf(fabsf(a.z), fabsf(a.w))));
      }
    mx = fmaxf(wave_max(mx), 1e-30f);
    const float sc = 224.f / mx;
    if (lane == 0) invs[r] = mx * (1.f / 224.f);
#pragma unroll
    for (int hsel = 0; hsel < 2; hsel++) {
      u32x4 o;
#pragma unroll
      for (int i = 0; i < 4; i++) {
        const float4 a = v[hsel * 4 + i];
        int w = __builtin_amdgcn_cvt_pk_fp8_f32(a.x * sc, a.y * sc, 0, false);
        w = __builtin_amdgcn_cvt_pk_fp8_f32(a.z * sc, a.w * sc, w, true);
        o[i] = (unsigned)w;
      }
      *(u32x4*)&dst[(size_t)r * 2048 + hsel * 1024 + lane * 16] = o;
    }
  }
}
DI void transpose_tiles_w(const float* __restrict__ W, bf16_t* __restrict__ Wt, int K, int N, float* wl, int widx, int nw) {
  const int lane = tid_() & 63;
  const int tn = N / 64, ntile = (K / 64) * tn;
  for (int tile = widx; tile < ntile; tile += nw) {
    const int k0 = (tile / tn) * 64, n0 = (tile % tn) * 64;
    const int r = lane >> 4, c4 = lane & 15;
#pragma unroll
    for (int i = 0; i < 16; i++) {
      const float4 v = *(const float4*)&W[(size_t)(k0 + r + 4 * i) * N + n0 + c4 * 4];
      float* d = &wl[(r + 4 * i) * 65 + c4 * 4]; d[0] = v.x; d[1] = v.y; d[2] = v.z; d[3] = v.w;
    }
    asm volatile("s_waitcnt lgkmcnt(0)" ::: "memory");
#pragma unroll
    for (int kc = 0; kc < 8; kc++) {
      u32x4 o;
#pragma unroll
      for (int j = 0; j < 4; j++) o[j] = pack2(wl[(kc * 8 + 2 * j) * 65 + lane], wl[(kc * 8 + 2 * j + 1) * 65 + lane]);
      *(u32x4*)&Wt[(size_t)(n0 + lane) * K + k0 + kc * 8] = o;
    }
    asm volatile("s_waitcnt lgkmcnt(0)" ::: "memory");
  }
}
DI void unpack16_fp8(u32x4 u, float* f) {
#pragma unroll
  for (int i = 0; i < 4; i++) {
    const auto lo = __builtin_amdgcn_cvt_pk_f32_fp8((int)u[i], false), hi = __builtin_amdgcn_cvt_pk_f32_fp8((int)u[i], true);
    f[i * 4] = lo[0]; f[i * 4 + 1] = lo[1]; f[i * 4 + 2] = hi[0]; f[i * 4 + 3] = hi[1];
  }
}

DI void phase_mod_partial(const Params& p) {
  const float* mod_w = p.in[IN_MOD_W]; const float* c = p.in[IN_C]; const float* cctx = p.in[IN_C_CTX];
  float* mpart = (float*)(p.ws + WS_MPART);
  for (int it = blockIdx.x; it < 768; it += gridDim.x) {
    const int l = it / 384, rem = it % 384, kc = rem / 6, jb = rem % 6;
    const int j = jb * 2048 + tid_() * 4;
    float4 a0 = {0, 0, 0, 0}, a1 = a0, a2 = a0;
    for (int kk = 0; kk < 32; kk++) {
      const int k = kc * 32 + kk;
      const float4 w = *(const float4*)&mod_w[((size_t)l * 2048 + k) * 12288 + j];
      float x0 = cctx[k], x1 = c[k], x2 = c[2048 + k];
      float s0 = x0 * sigmoidf_(x0), s1 = x1 * sigmoidf_(x1), s2 = x2 * sigmoidf_(x2);
      a0.x += s0 * w.x; a0.y += s0 * w.y; a0.z += s0 * w.z; a0.w += s0 * w.w;
      a1.x += s1 * w.x; a1.y += s1 * w.y; a1.z += s1 * w.z; a1.w += s1 * w.w;
      a2.x += s2 * w.x; a2.y += s2 * w.y; a2.z += s2 * w.z; a2.w += s2 * w.w;
    }
    float* o = mpart + ((size_t)(l * 64 + kc) * 3) * 12288 + j;
    *(float4*)o = a0; *(float4*)(o + 12288) = a1; *(float4*)(o + 2 * 12288) = a2;
  }
}
DI void phase_mod_reduce(const Params& p) {
  const float* mpart = (const float*)(p.ws + WS_MPART); float* m = (float*)(p.ws + WS_MOD); const float* mod_b = p.in[IN_MOD_B];
  for (int i = blockIdx.x * NTH + tid_(); i < 2 * 3 * 12288; i += gridDim.x * NTH) {
    const int l = i / 36864, rem = i % 36864, cv = rem / 12288, j = rem % 12288;
    float s = mod_b[l * 12288 + j];
    for (int kc = 0; kc < 64; kc++) s += mpart[((size_t)(l * 64 + kc) * 3 + cv) * 12288 + j];
    m[i] = s;
  }
}

DI void phase_hdn2(const Params& p) {
  const float* fw1 = p.in[IN_OC_FW1]; const float* fb1 = p.in[IN_OC_FB1]; const float* fr = p.in[IN_OC_FREQ];
  const float* fw2 = p.in[IN_OC_FW2]; const float* fb2 = p.in[IN_OC_FB2];
  float* hdn2 = (float*)(p.ws + WS_HDN2);
  const int lane = tid_() & 63, wave = tid_() >> 6;
  for (int row = blockIdx.x * 8 + wave; row < 4352; row += gridDim.x * 8) {
    const int L = row < 256 ? 256 : 4096, i = row < 256 ? row : row - 256;
    const float tl = (float)i / (float)(L - 1);
    const float wpos = 6.283185307179586f * (float)i / (float)L;
    float acc = fb1[lane] + tl * fw1[lane];
    for (int b = 0; b < 16; b++) {
      const float f = 1e-4f + (float)b * ((15.f - 1e-4f) / 15.f);
      const float ang = f * wpos;
      acc += cosf(ang) * fw1[(1 + b) * 64 + lane];
      acc += -sinf(ang) * fw1[(17 + b) * 64 + lane];
    }
    const float h1 = sinf(fr[lane] * acc);
    float acc2 = fb2[lane];
    for (int k = 0; k < 64; k++) acc2 += __shfl(h1, k) * fw2[k * 64 + lane];
    const float h2 = sinf(fr[lane] * acc2);
    hdn2[row * 64 + lane] = h2; ((bf16_t*)(p.ws + WS_HDN2B))[row * 64 + lane] = f2bf(h2);
  }
}

DI void phase_norm(const float* __restrict__ x0, const float* __restrict__ x1, const float* __restrict__ gamma,
                   const float* __restrict__ mod, int sh_off, int sc_off, bf16_t* __restrict__ hm) {
  const int lane = tid_() & 63, wave = tid_() >> 6;
  for (int t = blockIdx.x * 8 + wave; t < T; t += gridDim.x * 8) {
    const float* x = t < TP ? x0 + (size_t)t * 2048 : x1 + (size_t)(t - TP) * 2048;
    const float* m = mod + cvec_of(t) * 12288;
    float4 v[8]; float ss = 0;
#pragma unroll
    for (int i = 0; i < 8; i++) { v[i] = ((const float4*)x)[i * 64 + lane]; ss += v[i].x * v[i].x + v[i].y * v[i].y + v[i].z * v[i].z + v[i].w * v[i].w; }
    ss = wave_sum(ss);
    const float rstd = rsqrtf(ss * (1.f / 2048.f) + 1e-6f);
#pragma unroll
    for (int i = 0; i < 8; i++) {
      const int n = (i * 64 + lane) * 4;
      const float4 g = *(const float4*)&gamma[n], sc = *(const float4*)&m[sc_off + n], sh = *(const float4*)&m[sh_off + n];
      float a = v[i].x * rstd * g.x * (1.f + sc.x) + sh.x, b = v[i].y * rstd * g.y * (1.f + sc.y) + sh.y;
      float c = v[i].z * rstd * g.z * (1.f + sc.z) + sh.z, d = v[i].w * rstd * g.w * (1.f + sc.w) + sh.w;
      u32x2 o = {pack2(a, b), pack2(c, d)};
      *(u32x2*)&hm[(size_t)t * 2048 + n] = o;
    }
  }
}

template <int BN, class Epi>
DI void gemm_tile(const bf16_t* __restrict__ A, int lda, const bf16_t* __restrict__ Bt, int ldb, int m0, int n0, int N, int K, const Epi& epi, char* lds) {
  constexpr int WN = BN / 4, NJ = WN / 32, NB = BN / 64;
  constexpr int ROWB = 144;
  constexpr int STAGE = (256 + BN) * ROWB;
  const int tid = tid_(), wave = tid >> 6, lane = tid & 63, r32 = lane & 31, h = lane >> 5;
  const int wm = wave >> 2, wn = wave & 3;
  f32x16 acc[4][NJ];
#pragma unroll
  for (int i = 0; i < 4; i++)
#pragma unroll
    for (int j = 0; j < NJ; j++)
#pragma unroll
      for (int r = 0; r < 16; r++) acc[i][j][r] = 0.f;
  u32x4 ra[4], rb[NB];
  const int srow = tid >> 3, sc = tid & 7;
  const bf16_t* Ap = A + (size_t)(m0 + srow) * lda + sc * 8;
  const bf16_t* Bp[NB];
#pragma unroll
  for (int i = 0; i < NB; i++) { int n = n0 + srow + 64 * i; n = n < N ? n : N - 1; Bp[i] = Bt + (size_t)n * ldb + sc * 8; }
  auto gload = [&](int k0) {
#pragma unroll
    for (int i = 0; i < 4; i++) ra[i] = *(const u32x4*)(Ap + (size_t)(64 * i) * lda + k0);
#pragma unroll
    for (int i = 0; i < NB; i++) rb[i] = *(const u32x4*)(Bp[i] + k0);
  };
  auto swrite = [&](int st) {
    char* As = lds + st * STAGE; char* Bs = As + 256 * ROWB;
#pragma unroll
    for (int i = 0; i < 4; i++) *(u32x4*)(As + (srow + 64 * i) * ROWB + sc * 16) = ra[i];
#pragma unroll
    for (int i = 0; i < NB; i++) *(u32x4*)(Bs + (srow + 64 * i) * ROWB + sc * 16) = rb[i];
  };
  auto compute = [&](int st, int ks) {
    const char* As = lds + st * STAGE; const char* Bs = As + 256 * ROWB;
    bf16x8 af[4], bfr[NJ];
#pragma unroll
    for (int i = 0; i < 4; i++) af[i] = *(const bf16x8*)(As + (wm * 128 + i * 32 + r32) * ROWB + (ks * 16 + h * 8) * 2);
#pragma unroll
    for (int j = 0; j < NJ; j++) bfr[j] = *(const bf16x8*)(Bs + (wn * WN + j * 32 + r32) * ROWB + (ks * 16 + h * 8) * 2);
#pragma unroll
    for (int i = 0; i < 4; i++)
#pragma unroll
      for (int j = 0; j < NJ; j++) acc[i][j] = __builtin_amdgcn_mfma_f32_32x32x16_bf16(af[i], bfr[j], acc[i][j], 0, 0, 0);
  };
  const int KT = K / 64;
  __syncthreads();
  gload(0); swrite(0);
  if (KT > 1) gload(64);
  __syncthreads();
  for (int kt = 0; kt < KT; kt++) {
    const int st = kt & 1;
    compute(st, 0); compute(st, 1);
    if (kt + 1 < KT) { swrite(st ^ 1); if (kt + 2 < KT) gload((kt + 2) * 64); }
    compute(st, 2); compute(st, 3);
    __syncthreads();
  }
#pragma unroll
  for (int i = 0; i < 4; i++)
#pragma unroll
    for (int j = 0; j < NJ; j++) {
      const int n = n0 + wn * WN + j * 32 + r32;
      __builtin_amdgcn_sched_barrier(0);
      if (n < N) {
#pragma unroll
        for (int r = 0; r < 16; r++) {
          epi(m0 + wm * 128 + i * 32 + crow(r, h), n, acc[i][j][r]);
          if ((r + 1) % Epi::GROUP == 0) asm volatile("" ::: "memory");
        }
      }
    }
}
struct EpiBF16 { static constexpr int GROUP = 16; bf16_t* C; size_t ldc; DI void operator()(int m, int n, float v) const { C[(size_t)m * ldc + n] = f2bf(v); } };
struct EpiF32  { static constexpr int GROUP = 16; float* C; size_t ldc; DI void operator()(int m, int n, float v) const { C[(size_t)m * ldc + n] = v; } };
struct EpiW { static constexpr int GROUP = 16; float* W; const float* w0; int d;
  DI void operator()(int m, int n, float v) const { W[((size_t)m * 2 + d) * 1024 + n] = __expf(-0.6065306597f * sigmoidf_(w0[d * 1024 + n] + v)); } };
struct EpiA { static constexpr int GROUP = 16; bf16_t* Ab; const float* a0; int d;
  DI void operator()(int m, int n, float v) const { Ab[((size_t)m * 2 + d) * 1024 + n] = f2bf(sigmoidf_(a0[d * 1024 + n] + v)); } };
struct EpiRes { static constexpr int GROUP = 16; const float* xp; const float* xs; const float* gt; float* out;
  DI void operator()(int m, int n, float v) const {
    const float xin = m < TP ? xp[(size_t)m * 2048 + n] : xs[(size_t)(m - TP) * 2048 + n];
    out[(size_t)m * 2048 + n] = xin + gt[cvec_of(m) * 12288 + n] * v; } };

template <int BN, class Epi>
DI void gemm_full(const bf16_t* A, int lda, const bf16_t* Bt, int ldb, int M, int N, int K, const Epi& epi, char* lds) {
  const int tn = (N + BN - 1) / BN, ntile = (M / 256) * tn;
  for (int tile = blockIdx.x; tile < ntile; tile += gridDim.x) gemm_tile<BN>(A, lda, Bt, ldb, (tile / tn) * 256, (tile % tn) * BN, N, K, epi, lds);
}

constexpr int AD = 128, ANW = 8, AQBLK = 32, AKVBLK = 64;
constexpr float ASCALE = 0.088388347648318440f;
constexpr float ATHR = 8.f;
constexpr size_t SHM_V = AKVBLK * AD * 2, SHM_K = AKVBLK * AD * 2, SHM_ATTN = 2 * SHM_V + 2 * SHM_K + ANW * 64 * 4;
#define KSWZ(row, colB) ((row) * 256 + ((colB) ^ (((row) & 7) << 4)))
#define SBAR() __builtin_amdgcn_sched_barrier(0)
DI unsigned cvtpk(float lo, float hi) { unsigned r; asm volatile("v_cvt_pk_bf16_f32 %0, %1, %2" : "=v"(r) : "v"(lo), "v"(hi)); return r; }
DI void partialSM(f32x16& p0, f32x16& p1, float& m_reg, float& mn, float& alpha) {
  constexpr float C = ASCALE * 1.4426950408889634f;
  float pmax = p0[0];
#pragma unroll
  for (int r = 1; r < 16; ++r) pmax = fmaxf(pmax, p0[r]);
#pragma unroll
  for (int r = 0; r < 16; ++r) pmax = fmaxf(pmax, p1[r]);
  { auto rr = __builtin_amdgcn_permlane32_swap(__float_as_uint(pmax), __float_as_uint(pmax), false, false);
    pmax = fmaxf(__uint_as_float(rr[0]), __uint_as_float(rr[1])); }
  if (__builtin_expect(__all(pmax - m_reg <= ATHR / ASCALE), 1)) { mn = m_reg; alpha = 1.f; }
  else { mn = fmaxf(m_reg, pmax); alpha = __builtin_amdgcn_exp2f((m_reg - mn) * C); m_reg = mn; }
  float mnC = -mn * C;
#pragma unroll
  for (int r = 0; r < 16; ++r) p0[r] = fmaf(p0[r], C, mnC);
#pragma unroll
  for (int r = 0; r < 16; ++r) p1[r] = fmaf(p1[r], C, mnC);
#pragma unroll
  for (int r = 0; r < 16; ++r) p0[r] = __builtin_amdgcn_exp2f(p0[r]);
}
DI void finishSM(f32x16& p0, f32x16& p1, float alpha, float& l_reg, bf16x8& pa0, bf16x8& pa1, bf16x8& pa2, bf16x8& pa3) {
#pragma unroll
  for (int r = 0; r < 16; ++r) p1[r] = __builtin_amdgcn_exp2f(p1[r]);
  float ps = 0;
#pragma unroll
  for (int r = 0; r < 16; ++r) ps += p0[r];
#pragma unroll
  for (int r = 0; r < 16; ++r) ps += p1[r];
  { auto rr = __builtin_amdgcn_permlane32_swap(__float_as_uint(ps), __float_as_uint(ps), false, false);
    ps = __uint_as_float(rr[0]) + __uint_as_float(rr[1]); }
  l_reg = l_reg * alpha + ps;
#define PK4(P, BASE, OUT) do { unsigned a0 = cvtpk(P[BASE + 0], P[BASE + 1]), a1 = cvtpk(P[BASE + 2], P[BASE + 3]);   \
    unsigned b0 = cvtpk(P[BASE + 4], P[BASE + 5]), b1 = cvtpk(P[BASE + 6], P[BASE + 7]);                              \
    auto r0 = __builtin_amdgcn_permlane32_swap(a0, b0, false, false); auto r1 = __builtin_amdgcn_permlane32_swap(a1, b1, false, false); \
    u32x4 w = {r0[0], r1[0], r0[1], r1[1]}; OUT = *reinterpret_cast<bf16x8*>(&w); } while (0)
  PK4(p0, 0, pa0); PK4(p0, 8, pa1); PK4(p1, 0, pa2); PK4(p1, 8, pa3);
#undef PK4
}
DI void qkt(f32x16& p0, f32x16& p1, const bf16_t* Ks, const bf16x8* qr, int r32, int hi) {
#pragma unroll
  for (int r = 0; r < 16; ++r) { p0[r] = 0.f; p1[r] = 0.f; }
#pragma unroll
  for (int d0 = 0; d0 < 8; ++d0) { int cb = (d0 * 16 + hi * 8) * 2;
    bf16x8 b0 = *reinterpret_cast<const bf16x8*>((const char*)Ks + KSWZ(r32, cb));
    bf16x8 b1 = *reinterpret_cast<const bf16x8*>((const char*)Ks + KSWZ(32 + r32, cb));
    p0 = __builtin_amdgcn_mfma_f32_32x32x16_bf16(b0, qr[d0], p0, 0, 0, 0);
    p1 = __builtin_amdgcn_mfma_f32_32x32x16_bf16(b1, qr[d0], p1, 0, 0, 0); }
}
DI int v_st(int k, int c) { const int kk = (k & ~0xC) | ((k & 4) << 1) | ((k & 8) >> 1); return ((kk >> 3) * 4 + (c >> 5)) * 512 + ((kk & 7) * 32 + (c & 31)) * 2; }
DI int v_rd_base(int lane) { return ((lane & 3) << 3) | (((lane >> 2) & 3) << 6) | (((lane >> 4) & 1) << 5) | (((lane >> 5) & 1) << 8); }
constexpr int v_rd_off(int d0, int ks, int half) { return d0 * 512 + ks * 4096 + half * 2048; }
template <int OFF> DI s16x4 tr_read(int vb) {
  s16x4 r; asm volatile("ds_read_b64_tr_b16 %0, %1 offset:%2" : "=&v"(r) : "v"(vb), "i"(OFF) : "memory"); return r;
}
template <int D0> DI void pv_one(f32x16& od, int vb, bf16x8 pa0, bf16x8 pa1, bf16x8 pa2, bf16x8 pa3) {
  const s16x4 l0 = tr_read<v_rd_off(D0, 0, 0)>(vb), h0 = tr_read<v_rd_off(D0, 0, 1)>(vb), l1 = tr_read<v_rd_off(D0, 1, 0)>(vb), h1 = tr_read<v_rd_off(D0, 1, 1)>(vb);
  const s16x4 l2 = tr_read<v_rd_off(D0, 2, 0)>(vb), h2 = tr_read<v_rd_off(D0, 2, 1)>(vb), l3 = tr_read<v_rd_off(D0, 3, 0)>(vb), h3 = tr_read<v_rd_off(D0, 3, 1)>(vb);
  asm volatile("s_waitcnt lgkmcnt(0)" ::: "memory"); SBAR();
#define PK(L, H) (bf16x8){L[0], L[1], L[2], L[3], H[0], H[1], H[2], H[3]}
  od = __builtin_amdgcn_mfma_f32_32x32x16_bf16(pa0, PK(l0, h0), od, 0, 0, 0);
  od = __builtin_amdgcn_mfma_f32_32x32x16_bf16(pa1, PK(l1, h1), od, 0, 0, 0);
  od = __builtin_amdgcn_mfma_f32_32x32x16_bf16(pa2, PK(l2, h2), od, 0, 0, 0);
  od = __builtin_amdgcn_mfma_f32_32x32x16_bf16(pa3, PK(l3, h3), od, 0, 0, 0);
#undef PK
}
DI void pv_d0(f32x16* o, int vb, bf16x8 pa0, bf16x8 pa1, bf16x8 pa2, bf16x8 pa3) {
  pv_one<0>(o[0], vb, pa0, pa1, pa2, pa3); pv_one<1>(o[1], vb, pa0, pa1, pa2, pa3); pv_one<2>(o[2], vb, pa0, pa1, pa2, pa3); pv_one<3>(o[3], vb, pa0, pa1, pa2, pa3);
}
template <int LDQ, int LDK, int LDO>
DI void attn_dense_body(const bf16_t* __restrict__ Qb, const bf16_t* __restrict__ Kh, const bf16_t* __restrict__ Vh,
                        bf16_t* __restrict__ Ob, int seq, char* lds) {
  const int tid = tid_(), wid = tid >> 6, lane = tid & 63, r32 = lane & 31, hi = lane >> 5;
  bf16_t* V_lds = (bf16_t*)lds; bf16_t* K_lds = (bf16_t*)(lds + 2 * SHM_V);
  float* wsf = (float*)(lds + 2 * SHM_V + 2 * SHM_K) + wid * 64; float* li_l = wsf; float* al_l = wsf + 32;
  float m_reg = -1e30f, l_reg = 0; f32x16 o[4]; bf16x8 qr[8];
#pragma unroll
  for (int d = 0; d < 4; d++)
#pragma unroll
    for (int r = 0; r < 16; r++) o[d][r] = 0.f;
  const bf16_t* Qw = Qb + (long)(wid * AQBLK + r32) * LDQ + hi * 8;
#pragma unroll
  for (int d0 = 0; d0 < 8; ++d0) qr[d0] = *reinterpret_cast<const bf16x8*>(Qw + d0 * 16);
  const int sr = tid >> 4, sc = (tid & 15) * 8, vst0 = v_st(sr, sc), vst1 = v_st(32 + sr, sc);
  const int vb0 = (int)(uintptr_t)V_lds + v_rd_base(lane);
  struct { bf16x8 vs0, vs1, ks0, ks1; } sr_[2];
#define SLOAD(i, k0) do { sr_[i].vs0 = *(const bf16x8*)(&Vh[(long)((k0) + sr) * LDK + sc]); sr_[i].vs1 = *(const bf16x8*)(&Vh[(long)((k0) + 32 + sr) * LDK + sc]); \
    sr_[i].ks0 = *(const bf16x8*)(&Kh[(long)((k0) + sr) * LDK + sc]); sr_[i].ks1 = *(const bf16x8*)(&Kh[(long)((k0) + 32 + sr) * LDK + sc]); } while (0)
#define SWRITE(b, i) do { *(bf16x8*)((char*)V_lds + (b) * SHM_V + vst0) = sr_[i].vs0;          \
    *(bf16x8*)((char*)V_lds + (b) * SHM_V + vst1) = sr_[i].vs1; int kc = sc * 2;               \
    *(bf16x8*)((char*)K_lds + (b) * SHM_K + KSWZ(sr, kc)) = sr_[i].ks0;                       \
    *(bf16x8*)((char*)K_lds + (b) * SHM_K + KSWZ(32 + sr, kc)) = sr_[i].ks1; } while (0)
#define SWAIT() do { asm volatile("s_waitcnt vmcnt(4)" ::: "memory"); } while (0)
#define RESC(a) do { if (__any((a) < 1.f)) { if (hi == 0) al_l[r32] = (a); asm volatile("s_waitcnt lgkmcnt(0)" ::: "memory"); \
    _Pragma("unroll") for (int d = 0; d < 4; ++d) _Pragma("unroll") for (int r = 0; r < 16; ++r) o[d][r] *= al_l[crow(r, hi)]; } } while (0)
  f32x16 pA0, pA1, pB0, pB1; float mnA, mnB, alA, alB; bf16x8 pa0, pa1, pa2, pa3; const int NTL = seq / AKVBLK;
  constexpr int SE = 0, SO = 1;
  SLOAD(SE, 0); asm volatile("s_waitcnt vmcnt(0)" ::: "memory"); SWRITE(0, SE); __syncthreads();
  qkt(pA0, pA1, K_lds, qr, r32, hi); partialSM(pA0, pA1, m_reg, mnA, alA);
  SLOAD(SO, AKVBLK); if (2 < NTL) SLOAD(SE, 2 * AKVBLK);
  SWAIT(); SWRITE(1, SO); __syncthreads();
  for (int j = 1; j + 1 < NTL; j += 2) {
    SBAR(); qkt(pB0, pB1, (bf16_t*)((char*)K_lds + SHM_K), qr, r32, hi);
    finishSM(pA0, pA1, alA, l_reg, pa0, pa1, pa2, pa3); SBAR();
    SLOAD(SO, (j + 2) * AKVBLK); SBAR();
    pv_d0(o, vb0, pa0, pa1, pa2, pa3); partialSM(pB0, pB1, m_reg, mnB, alB);
    __syncthreads(); SWAIT(); SWRITE(0, SE);
    RESC(alB); __syncthreads();
    SBAR(); qkt(pA0, pA1, K_lds, qr, r32, hi);
    finishSM(pB0, pB1, alB, l_reg, pa0, pa1, pa2, pa3); SBAR();
    if (j + 3 < NTL) SLOAD(SE, (j + 3) * AKVBLK); SBAR();
    pv_d0(o, vb0 + (int)SHM_V, pa0, pa1, pa2, pa3); partialSM(pA0, pA1, m_reg, mnA, alA);
    __syncthreads(); SWAIT(); SWRITE(1, SO);
    RESC(alA); __syncthreads();
  }
  SBAR(); qkt(pB0, pB1, (bf16_t*)((char*)K_lds + SHM_K), qr, r32, hi);
  finishSM(pA0, pA1, alA, l_reg, pa0, pa1, pa2, pa3); SBAR();
  pv_d0(o, vb0, pa0, pa1, pa2, pa3); partialSM(pB0, pB1, m_reg, mnB, alB);
  __syncthreads(); RESC(alB);
  finishSM(pB0, pB1, alB, l_reg, pa0, pa1, pa2, pa3); SBAR();
  pv_d0(o, vb0 + (int)SHM_V, pa0, pa1, pa2, pa3);
  if (hi == 0) li_l[r32] = l_reg; asm volatile("s_waitcnt lgkmcnt(0)" ::: "memory");
  float rli[16];
#pragma unroll
  for (int r = 0; r < 16; ++r) rli[r] = __builtin_amdgcn_rcpf(li_l[crow(r, hi)]);
  bf16_t* Ow = Ob + (long)(wid * AQBLK) * LDO;
#pragma unroll
  for (int r = 0; r < 16; ++r) { int orow = crow(r, hi);
#pragma unroll
    for (int d0 = 0; d0 < 4; ++d0) { const float ov = o[d0][r] * rli[r]; Ow[(long)orow * LDO + d0 * 32 + r32] = (bf16_t)(cvtpk(ov, ov) & 0xffffu); } }
#undef SLOAD
#undef SWRITE
#undef SWAIT
#undef RESC
}

DI void phase_prep0(const Params& p, char* lds) {
  const bf16_t* z0 = (const bf16_t*)(p.ws + WS_Z0);
  bf16_t* Qb = (bf16_t*)(p.ws + WS_QB);
  bf16_t* Kbp = (bf16_t*)(p.ws + WS_KBP); bf16_t* Vbp = (bf16_t*)(p.ws + WS_VBP);
  bf16_t* Kbs = (bf16_t*)(p.ws + WS_KBS); bf16_t* Vbs = (bf16_t*)(p.ws + WS_VBS);
  const float* qn = p.in[IN_EB_QN]; const float* kn = p.in[IN_EB_KN];
  float* outk = p.out + OUT_NK; float* outv = p.out + OUT_NV;
  const int tid = tid_(), lane = tid & 63, wave = tid >> 6;
  float* R = (float*)(p.ws + WS_R); float* KK = (float*)(p.ws + WS_KK); float* V = (float*)(p.ws + WS_V);
  float* KT = (float*)(p.ws + WS_KT);
  float* BON = (float*)(p.ws + WS_BON); bf16_t* actA = (bf16_t*)(p.ws + WS_ACTA);
  const float* k_k = p.in[IN_EA_KK]; const float* r_k = p.in[IN_EA_RK];
  float* cwl = (float*)lds;
  __syncthreads();
  for (int i = tid; i < 3 * 3456; i += NTH) cwl[i] = p.in[IN_EA_CONV][i];
  __syncthreads();
  for (int t = blockIdx.x * 8 + wave; t < T; t += gridDim.x * 8) {
    const bf16_t* zr = z0 + (size_t)t * ZC;
    const bool latent = t >= TP;
    const int tl = latent ? ((t - TP) & 4095) : (t & 255);
    const int L = latent ? 4096 : 256;
    const bool hasp = tl > 0, hasn = tl < L - 1;
    const float hp = hasp ? 1.f : 0.f, hn = hasn ? 1.f : 0.f;
    const bf16_t* zpr = hasp ? zr - ZC : zr; const bf16_t* znr = hasn ? zr + ZC : zr;
    float ze[20];
#pragma unroll
    for (int hh = 0; hh < 10; hh++) { ze[2 * hh] = bf2f(zr[3456 + hh * 128 + lane]); ze[2 * hh + 1] = bf2f(zr[3456 + hh * 128 + 64 + lane]); }
    const u32x2 vraw = *(const u32x2*)&zr[3456 + 1280 + lane * 4];
    u32x4 zz[3][2][3];
#pragma unroll
    for (int sec = 0; sec < 3; sec++)
#pragma unroll
      for (int hv = 0; hv < 2; hv++) {
        const int col = sec * 1024 + lane * 16 + hv * 8;
        zz[sec][hv][0] = *(const u32x4*)&zpr[col]; zz[sec][hv][1] = *(const u32x4*)&zr[col]; zz[sec][hv][2] = *(const u32x4*)&znr[col];
      }
    u32x4 zl[3];
    { const int col = 3072 + (lane < 48 ? lane : 0) * 8;
      zl[0] = *(const u32x4*)&zpr[col]; zl[1] = *(const u32x4*)&zr[col]; zl[2] = *(const u32x4*)&znr[col]; }
    {
      float cs0 = 1.f, sn0 = 0.f, cs1 = 1.f, sn1 = 0.f;
      if (latent) {
        const int i = lane & 31;
        const float inv = exp2f(-(float)i * 0.41524101186092029f);
        const float a0 = (float)(tl >> 6) * inv, a1 = (float)(tl & 63) * inv;
        cs0 = __cosf(a0); sn0 = __sinf(a0); cs1 = __cosf(a1); sn1 = __sinf(a1);
      }
      const float g0q = qn[lane], g1q = qn[64 + lane], g0k = kn[lane], g1k = kn[64 + lane];
#pragma unroll
      for (int hh = 0; hh < 10; hh++) {
        float e0 = ze[2 * hh], e1 = ze[2 * hh + 1];
        const float ss = wave_sum(e0 * e0 + e1 * e1);
        const float rstd = rsqrtf(ss * (1.f / 128.f) + 1e-6f);
        const bool isq = hh < 8;
        e0 *= rstd * (isq ? g0q : g0k); e1 *= rstd * (isq ? g1q : g1k);
        if (!isq && !latent) {
          const size_t o = (size_t)t * 256 + (hh - 8) * 128;
          outk[o + lane] = e0; outk[o + 64 + lane] = e1;
        }
        if (latent) {
          const float p0 = __shfl_xor(e0, 32), p1 = __shfl_xor(e1, 32);
          if (lane < 32) { e0 = e0 * cs0 - p0 * sn0; e1 = e1 * cs1 - p1 * sn1; }
          else           { e0 = p0 * sn0 + e0 * cs0; e1 = p1 * sn1 + e1 * cs1; }
        }
        if (isq) {
          bf16_t* q = Qb + (size_t)t * 1024 + hh * 128; q[lane] = f2bf(e0); q[64 + lane] = f2bf(e1);
        } else {
          bf16_t* k;
          if (!latent) k = Kbp + (size_t)t * 256 + (hh - 8) * 128;
          else { const int b = (t - TP) >> 12; k = Kbs + ((size_t)b * SKV_S + tl) * 256 + (hh - 8) * 128; }
          k[lane] = f2bf(e0); k[64 + lane] = f2bf(e1);
        }
      }
      {
        bf16_t* vd;
        if (!latent) {
          vd = Vbp + (size_t)t * 256 + lane * 4;
          float4 f = {lo2f(vraw[0]), hi2f(vraw[0]), lo2f(vraw[1]), hi2f(vraw[1])};
          *(float4*)&outv[(size_t)t * 256 + lane * 4] = f;
        } else { const int b = (t - TP) >> 12; vd = Vbs + ((size_t)b * SKV_S + tl) * 256 + lane * 4; }
        *(u32x2*)vd = vraw;
      }
    }
    {
      const int c0 = lane * 16;
      auto conv_sec = [&](int sec, float* dst) {
#pragma unroll
        for (int hv = 0; hv < 2; hv++) {
          const int col = sec * 1024 + lane * 16 + hv * 8;
          float zc[8], zp[8], zn[8];
          unpack8(zz[sec][hv][0], zp); unpack8(zz[sec][hv][1], zc); unpack8(zz[sec][hv][2], zn);
#pragma unroll
          for (int e4 = 0; e4 < 2; e4++) {
            const float4 w0 = *(const float4*)&cwl[col + e4 * 4], w1 = *(const float4*)&cwl[3456 + col + e4 * 4], w2 = *(const float4*)&cwl[6912 + col + e4 * 4];
            dst[hv * 8 + e4 * 4 + 0] = hp * zp[e4 * 4 + 0] * w0.x + zc[e4 * 4 + 0] * w1.x + hn * zn[e4 * 4 + 0] * w2.x;
            dst[hv * 8 + e4 * 4 + 1] = hp * zp[e4 * 4 + 1] * w0.y + zc[e4 * 4 + 1] * w1.y + hn * zn[e4 * 4 + 1] * w2.y;
            dst[hv * 8 + e4 * 4 + 2] = hp * zp[e4 * 4 + 2] * w0.z + zc[e4 * 4 + 2] * w1.z + hn * zn[e4 * 4 + 2] * w2.z;
            dst[hv * 8 + e4 * 4 + 3] = hp * zp[e4 * 4 + 3] * w0.w + zc[e4 * 4 + 3] * w1.w + hn * zn[e4 * 4 + 3] * w2.w;
          }
        }
      };
      float kk[16], tmp[16];
      conv_sec(1, kk);
      float ss = 0.f;
#pragma unroll
      for (int e = 0; e < 16; e++) { tmp[e] = kk[e] * k_k[c0 + e]; ss += tmp[e] * tmp[e]; }
      ss += __shfl_xor(ss, 1); ss += __shfl_xor(ss, 2);
      const float rn = rsqrtf(ss + 1e-12f);
#pragma unroll
      for (int e = 0; e < 16; e++) tmp[e] *= rn;
#pragma unroll
      for (int e4 = 0; e4 < 4; e4++) {
        const size_t o1 = (size_t)t * 1024 + c0 + e4 * 4, o2 = (size_t)t * 2048 + c0 + e4 * 4;
        const float4 k4 = {kk[e4 * 4], kk[e4 * 4 + 1], kk[e4 * 4 + 2], kk[e4 * 4 + 3]};
        const float4 n4 = {tmp[e4 * 4], tmp[e4 * 4 + 1], tmp[e4 * 4 + 2], tmp[e4 * 4 + 3]};
        *(float4*)&KK[o1] = n4;
        *(float4*)&KT[o2] = k4;
      }
      conv_sec(0, tmp);
      float bs = 0.f;
#pragma unroll
      for (int e = 0; e < 16; e++) bs += tmp[e] * kk[e] * r_k[c0 + e];
      bs += __shfl_xor(bs, 1); bs += __shfl_xor(bs, 2);
      if ((lane & 3) == 0) BON[(size_t)t * 16 + (lane >> 2)] = bs;
#pragma unroll
      for (int e4 = 0; e4 < 4; e4++) {
        const float4 r4 = {tmp[e4 * 4], tmp[e4 * 4 + 1], tmp[e4 * 4 + 2], tmp[e4 * 4 + 3]};
        *(float4*)&R[(size_t)t * 1024 + c0 + e4 * 4] = r4;
      }
      conv_sec(2, tmp);
#pragma unroll
      for (int e4 = 0; e4 < 4; e4++) {
        const float4 v4 = {tmp[e4 * 4], tmp[e4 * 4 + 1], tmp[e4 * 4 + 2], tmp[e4 * 4 + 3]};
        *(float4*)&V[(size_t)t * 1024 + c0 + e4 * 4] = v4;
      }
      if (lane < 48) {
        const int col = 3072 + lane * 8;
        float zc[8], zp[8], zn[8];
        unpack8(zl[0], zp); unpack8(zl[1], zc); unpack8(zl[2], zn);
        float o[8];
#pragma unroll
        for (int e = 0; e < 8; e++) {
          float x = hp * zp[e] * cwl[col + e] + zc[e] * cwl[3456 + col + e] + hn * zn[e] * cwl[6912 + col + e];
          if (lane < 16) x = tanhf(x); else if (lane >= 32) x = sigmoidf_(x);
          o[e] = x;
        }
        u32x4 ov = {pack2(o[0], o[1]), pack2(o[2], o[3]), pack2(o[4], o[5]), pack2(o[6], o[7])};
        *(u32x4*)&actA[(size_t)t * 384 + lane * 8] = ov;
      }
    }
  }
  {
    const float* ck = p.in[IN_CACHE_K]; const float* cvv = p.in[IN_CACHE_V];
    for (int i = blockIdx.x * NTH + tid_(); i < 2 * 512 * 256; i += gridDim.x * NTH) {
      const int b = i / (512 * 256), rem = i % (512 * 256);
      const size_t o = ((size_t)b * SKV_S + 4096) * 256 + rem;
      Kbs[o] = f2bf(ck[i]); Vbs[o] = f2bf(cvv[i]);
    }
  }
}

DI void phase_fixa(const Params& p) {
  float* KKA = (float*)(p.ws + WS_KKA); float* KT = (float*)(p.ws + WS_KT); const float* KK = (const float*)(p.ws + WS_KK); const float* ka = p.in[IN_EA_KA];
  for (int i = blockIdx.x * NTH + tid_(); i < T * 256; i += gridDim.x * NTH) {
    const int t = i >> 8, n = (i & 255) * 4;
    const size_t o1 = (size_t)t * 1024 + n, o2 = (size_t)t * 2048 + n;
    const bf16_t* Ab = (const bf16_t*)(p.ws + WS_UB);
    const u32x2 ab0 = *(const u32x2*)&Ab[o2], ab1 = *(const u32x2*)&Ab[o2 + 1024];
    const float4 a0 = {lo2f(ab0[0]), hi2f(ab0[0]), lo2f(ab0[1]), hi2f(ab0[1])}, a1 = {lo2f(ab1[0]), hi2f(ab1[0]), lo2f(ab1[1]), hi2f(ab1[1])};
    const float4 kk = *(const float4*)&KK[o1], k = *(const float4*)&KT[o2], c = *(const float4*)&ka[n];
    float4 r;
    r.x = kk.x * a0.x; r.y = kk.y * a0.y; r.z = kk.z * a0.z; r.w = kk.w * a0.w; *(float4*)&KKA[o2] = r;
    r.x = kk.x * a1.x; r.y = kk.y * a1.y; r.z = kk.z * a1.z; r.w = kk.w * a1.w; *(float4*)&KKA[o2 + 1024] = r;
    r.x = k.x * (1.f + (a0.x - 1.f) * c.x); r.y = k.y * (1.f + (a0.y - 1.f) * c.y); r.z = k.z * (1.f + (a0.z - 1.f) * c.z); r.w = k.w * (1.f + (a0.w - 1.f) * c.w); *(float4*)&KT[o2] = r;
    r.x = k.x * (1.f + (a1.x - 1.f) * c.x); r.y = k.y * (1.f + (a1.y - 1.f) * c.y); r.z = k.z * (1.f + (a1.z - 1.f) * c.z); r.w = k.w * (1.f + (a1.w - 1.f) * c.w); *(float4*)&KT[o2 + 1024] = r;
  }
}

typedef float f2v __attribute__((ext_vector_type(2)));
template <int RPL> struct ScanBuf { f2v kk[2], w[2], kka[2], kt[2], r[2]; float v[RPL]; };
template <int RPL, int DEP>
DI void scan_item(const Params& p, int tok0, int L, int dir, int head, int row0, const float* s0, float* sfin) {
  const int lane = tid_() & 63;
  const int g = lane >> 4, kq = lane & 15, k0 = kq * 4, rbase = row0 + g * RPL;
  const char* Rb = p.ws + WS_R; const char* KKb = p.ws + WS_KK; const char* Vb = p.ws + WS_V;
  const char* Wb = p.ws + WS_W; const char* KKAb = p.ws + WS_KKA; const char* KTb = p.ws + WS_KT;
  char* Yb = (char*)p.out;
  const unsigned c1 = (unsigned)(head * 64 + k0) * 4u, cv = (unsigned)(head * 64 + rbase) * 4u;
  const unsigned c2 = (unsigned)(dir * 1024 + head * 64 + k0) * 4u, cy = (unsigned)(dir * 1024 + head * 64 + rbase + (kq < RPL ? kq : 0)) * 4u;
  f2v S[RPL][2];
#pragma unroll
  for (int j = 0; j < RPL; j++)
#pragma unroll
    for (int e = 0; e < 2; e++) {
      S[j][e][0] = s0 ? s0[(rbase + j) * 64 + k0 + 2 * e] : 0.f; S[j][e][1] = s0 ? s0[(rbase + j) * 64 + k0 + 2 * e + 1] : 0.f;
    }
  ScanBuf<RPL> buf[DEP];
  auto load = [&](ScanBuf<RPL>& b, int step) {
    const unsigned tok = (unsigned)(tok0 + (dir ? L - 1 - step : step));
    const unsigned o1 = tok * 4096u + c1, o2 = tok * 8192u + c2;
    const float4 a = *(const float4*)(KKb + o1); b.kk[0] = f2v{a.x, a.y}; b.kk[1] = f2v{a.z, a.w};
    const float4 c = *(const float4*)(Rb + o1); b.r[0] = f2v{c.x, c.y}; b.r[1] = f2v{c.z, c.w};
    const float4 d = *(const float4*)(Wb + o2); b.w[0] = f2v{d.x, d.y}; b.w[1] = f2v{d.z, d.w};
    const float4 f = *(const float4*)(KKAb + o2); b.kka[0] = f2v{f.x, f.y}; b.kka[1] = f2v{f.z, f.w};
    const float4 h = *(const float4*)(KTb + o2); b.kt[0] = f2v{h.x, h.y}; b.kt[1] = f2v{h.z, h.w};
    if constexpr (RPL == 2) { const float2 v = *(const float2*)(Vb + tok * 4096u + cv); b.v[0] = v.x; b.v[1] = v.y; }
    else { const float4 v = *(const float4*)(Vb + tok * 4096u + cv); b.v[0] = v.x; b.v[1] = v.y; b.v[2] = v.z; b.v[3] = v.w; }
  };
#pragma unroll
  for (int d = 0; d < DEP; d++) { load(buf[d], d); __builtin_amdgcn_sched_barrier(0); }
  for (int sb = 0; sb < L; sb += DEP) {
#pragma unroll
    for (int d = 0; d < DEP; d++) {
      const int step = sb + d;
      ScanBuf<RPL>& b = buf[d];
      float sa[RPL], y[RPL];
#pragma unroll
      for (int j = 0; j < RPL; j++) { const f2v t = S[j][0] * b.kk[0] + S[j][1] * b.kk[1]; sa[j] = t[0] + t[1]; }
#pragma unroll
      for (int j = 0; j < RPL; j++) sa[j] = row_reduce<16>(sa[j]);
#pragma unroll
      for (int j = 0; j < RPL; j++) {
        const f2v nsa = {-sa[j], -sa[j]}, vv = {b.v[j], b.v[j]};
        f2v t0 = vv * b.kt[0], t1 = vv * b.kt[1];
        t0 = nsa * b.kka[0] + t0; t1 = nsa * b.kka[1] + t1;
        S[j][0] = S[j][0] * b.w[0] + t0; S[j][1] = S[j][1] * b.w[1] + t1;
        const f2v ya = S[j][0] * b.r[0] + S[j][1] * b.r[1];
        y[j] = ya[0] + ya[1];
      }
#pragma unroll
      for (int j = 0; j < RPL; j++) y[j] = row_reduce<16>(y[j]);
      float ysel = y[0];
#pragma unroll
      for (int j = 1; j < RPL; j++) ysel = (kq == j) ? y[j] : ysel;
      const unsigned tok = (unsigned)(tok0 + (dir ? L - 1 - step : step));
      if (kq < RPL) *(float*)(Yb + tok * 8192u + cy) = ysel;
      __builtin_amdgcn_sched_barrier(0);
      load(b, step + DEP < L ? step + DEP : L - 1);
      __builtin_amdgcn_sched_barrier(0);
    }
  }
  if (sfin) {
#pragma unroll
    for (int j = 0; j < RPL; j++)
#pragma unroll
      for (int e = 0; e < 2; e++) { sfin[(rbase + j) * 64 + k0 + 2 * e] = S[j][e][0]; sfin[(rbase + j) * 64 + k0 + 2 * e + 1] = S[j][e][1]; }
  }
}
DI void phase_scan(const Params& p, char* lds) {
  const int wave = tid_() >> 6;
  if (wave < 2) {
    for (int it = blockIdx.x * 2 + wave; it < 512; it += gridDim.x * 2) {
      const int rg = it & 7, hsd = it >> 3, head = hsd & 15, dir = (hsd >> 4) & 1, b = hsd >> 5;
      const float* s0 = p.in[IN_STATE_A] + ((size_t)(b * 2 + dir) * 16 + head) * 4096;
      scan_item<2, 8>(p, TP + b * 4096, 4096, dir, head, rg * 8, s0, nullptr);
    }
  } else if ((wave & 3) >= 2) {
    const int w4 = (wave & 1) + ((wave >> 2) << 1);
    for (int it = blockIdx.x * 4 + w4; it < 4096; it += gridDim.x * 4) {
      const int rg = it & 3, hsd = it >> 2, head = hsd & 15, dir = (hsd >> 4) & 1, b = hsd >> 5;
      float* sf = p.out + OUT_NS + ((size_t)(b * 2 + dir) * 16 + head) * 4096;
      scan_item<4, 4>(p, b * 256, 256, dir, head, rg * 16, nullptr, sf);
    }
    const int widx = blockIdx.x * 4 + w4, nw = gridDim.x * 4;
    float* wl = (float*)lds + w4 * (64 * 65);
    transpose_tiles_w(p.in[IN_EW_OUT], (bf16_t*)(p.ws + WS_WT_OUT0), 2048, 2048, wl, widx, nw);
    convert_fp8_rows_w(p.in[IN_PEER_U], (unsigned char*)(p.ws + WS_UB), (float*)(p.ws + WS_TSC), 32768, widx, nw);
    convert_fp8_rows_w(p.in[IN_PEER_V], (unsigned char*)(p.ws + WS_VB), (float*)(p.ws + WS_TSC) + 32768, 32768, widx, nw);
    transpose_tiles_w(p.in[IN_PEER_WQ], (bf16_t*)(p.ws + WS_WT_Q), 2048, 2048, wl, widx, nw);
    transpose_tiles_w(p.in[IN_OW_IN], (bf16_t*)(p.ws + WS_WT_IN1), 2048, 6144, wl, widx, nw);
    transpose_tiles_w(p.in[IN_OW_OUT], (bf16_t*)(p.ws + WS_WT_OUT1), 2048, 2048, wl, widx, nw);
    transpose_tiles_w(p.in[IN_PEER_WQ] + (size_t)2048 * 2048, (bf16_t*)(p.ws + WS_WT_Q) + (size_t)2048 * 2048, 2048, 2048, wl, widx, nw);
    transpose_tiles_w(p.in[IN_OC_FW3], (bf16_t*)(p.ws + WS_FW3T), 64, 8192, wl, widx, nw);
  }
}

DI void phase_post0(const Params& p) {
  const float* ydir = p.out; const float* V = (const float*)(p.ws + WS_V); const bf16_t* G = (const bf16_t*)(p.ws + WS_G);
  const float* BON = (const float*)(p.ws + WS_BON); const float* lnw = p.in[IN_EA_LNW]; const float* lnb = p.in[IN_EA_LNB];
  bf16_t* A2 = (bf16_t*)(p.ws + WS_A2);
  const int lane = tid_() & 63, wave = tid_() >> 6;
  for (int t = blockIdx.x * 8 + wave; t < T; t += gridDim.x * 8) {
    const int c0 = lane * 16;
    float y[16]; float s = 0.f;
#pragma unroll
    for (int e4 = 0; e4 < 4; e4++) {
      const float4 a = *(const float4*)&ydir[(size_t)t * 2048 + c0 + e4 * 4], b = *(const float4*)&ydir[(size_t)t * 2048 + 1024 + c0 + e4 * 4];
      y[e4 * 4] = a.x + b.x; y[e4 * 4 + 1] = a.y + b.y; y[e4 * 4 + 2] = a.z + b.z; y[e4 * 4 + 3] = a.w + b.w;
    }
#pragma unroll
    for (int e = 0; e < 16; e++) s += y[e];
    s += __shfl_xor(s, 1); s += __shfl_xor(s, 2);
    const float mu = s * (1.f / 64.f);
    float vs = 0.f;
#pragma unroll
    for (int e = 0; e < 16; e++) { const float d = y[e] - mu; vs += d * d; }
    vs += __shfl_xor(vs, 1); vs += __shfl_xor(vs, 2);
    const float rstd = rsqrtf(vs * (1.f / 64.f) + 64e-5f);
    const float bon = BON[(size_t)t * 16 + (lane >> 2)];
    float o[16];
#pragma unroll
    for (int e = 0; e < 16; e++) {
      const float yn = (y[e] - mu) * rstd * lnw[c0 + e] + lnb[c0 + e];
      o[e] = (yn + bon * V[(size_t)t * 1024 + c0 + e]) * bf2f(G[(size_t)t * 1024 + c0 + e]);
    }
    u32x4 o0 = {pack2(o[0], o[1]), pack2(o[2], o[3]), pack2(o[4], o[5]), pack2(o[6], o[7])};
    u32x4 o1 = {pack2(o[8], o[9]), pack2(o[10], o[11]), pack2(o[12], o[13]), pack2(o[14], o[15])};
    *(u32x4*)&A2[(size_t)t * 2048 + c0] = o0; *(u32x4*)&A2[(size_t)t * 2048 + c0 + 8] = o1;
  }
}

template <int CTRL> DI unsigned dppu(unsigned x) { return (unsigned)__builtin_amdgcn_update_dpp(0, (int)x, CTRL, 0xf, 0xf, false); }
DI unsigned wave_max_u(unsigned v) {
  v = max(v, dppu<0xB1>(v)); v = max(v, dppu<0x4E>(v)); v = max(v, dppu<0x141>(v)); v = max(v, dppu<0x140>(v));
  const unsigned a = __builtin_amdgcn_readlane((int)v, 0), b = __builtin_amdgcn_readlane((int)v, 16), c = __builtin_amdgcn_readlane((int)v, 32), d = __builtin_amdgcn_readlane((int)v, 48);
  return max(max(a, b), max(c, d));
}
DI unsigned mkkey(float s, int idx) { unsigned u = __float_as_uint(s); u ^= (u >> 31) ? 0xffffffffu : 0x80000000u; return (u & ~0xffu) | (unsigned)(255 - idx); }
DI float keyval(unsigned k) { unsigned u = k & ~0xffu; u ^= (u >> 31) ? 0x80000000u : 0xffffffffu; return __uint_as_float(u); }
DI unsigned top16_keys2(unsigned k0, unsigned k1, int lane) {
  unsigned res = 0;
  for (int it = 0; it < 16; it++) {
    const unsigned m = wave_max_u(max(k0, k1));
    if (k0 == m) k0 = 0; if (k1 == m) k1 = 0;
    if (lane == it) res = m;
  }
  return res;
}
DI void topk_one(const float* __restrict__ s, int lane, int ci, int cj, bool cvalid, int& e_out, float& g_out) {
  const unsigned r1 = top16_keys2(mkkey(s[lane], lane), mkkey(s[64 + lane], 64 + lane), lane);
  const unsigned r2 = top16_keys2(mkkey(s[128 + lane], lane), mkkey(s[192 + lane], 64 + lane), lane);
  const float s1 = keyval(r1), s2 = keyval(r2);
  const int i1 = 255 - (int)(r1 & 0xffu), i2 = 255 - (int)(r2 & 0xffu);
  const float cand = __shfl(s1, ci) + __shfl(s2, cj);
  unsigned ck = cvalid ? mkkey(cand, lane) : 0u;
  unsigned rt = 0;
  for (int it = 0; it < 16; it++) {
    const unsigned m = wave_max_u(ck);
    if (ck == m) ck = 0;
    if (lane == it) rt = m;
  }
  const float tv = keyval(rt);
  const int cl = 255 - (int)(rt & 0xffu);
  const int wi = __shfl(ci, cl & 63), wj = __shfl(cj, cl & 63);
  const int e1 = __shfl(i1, wi), e2 = __shfl(i2, wj);
  const float mx = __shfl(tv, 0);
  const float ex = lane < 16 ? __expf(tv - mx) : 0.f;
  const float sum = wave_sum(ex);
  e_out = (e1 * 128 + e2) & 16383; g_out = ex / sum;
}

typedef float f2g __attribute__((ext_vector_type(2)));
struct GBuf { u32x4 u[2][2], v[2][2]; };
DI void phase_gather(const Params& p, int layer, char* lds) {
  const bf16_t* hm = (const bf16_t*)(p.ws + WS_HM);
  const unsigned char* ub = (const unsigned char*)(p.ws + WS_UB) + (size_t)layer * 16384 * 2048;
  const unsigned char* vb = (const unsigned char*)(p.ws + WS_VB) + (size_t)layer * 16384 * 2048;
  const float* usc = (const float*)(p.ws + WS_TSC) + layer * 16384;
  const float* vsc = (const float*)(p.ws + WS_TSC) + 32768 + layer * 16384;
  const float* sc = (const float*)(p.ws + WS_SC);
  const float* mod = (const float*)(p.ws + WS_MOD) + layer * 36864;
  float* xbuf = p.out; float* red = (float*)lds;
  const int tid = tid_(), lane = tid & 63, wave = tid >> 6;
  int ci = 0, cj = 0; bool cvalid = false;
  { int base = 0;
    for (int i = 0; i < 16; i++) { const int cnt = 16 / (i + 1); if (lane >= base && lane < base + cnt) { ci = i; cj = lane - base; cvalid = true; } base += cnt; } }
  const unsigned lo16 = (unsigned)lane * 16u;
  auto gl = [&](GBuf& b, int e_lanes, int g) {
#pragma unroll
    for (int jj = 0; jj < 2; jj++) {
      const unsigned e = (unsigned)__builtin_amdgcn_readlane(e_lanes, 2 * g + jj);
      const unsigned char* ur = ub + (size_t)e * 2048 + lo16; const unsigned char* vr = vb + (size_t)e * 2048 + lo16;
      b.u[jj][0] = *(const u32x4*)ur; b.u[jj][1] = *(const u32x4*)(ur + 1024);
      b.v[jj][0] = *(const u32x4*)vr; b.v[jj][1] = *(const u32x4*)(vr + 1024);
    }
  };
  int t = blockIdx.x;
  int e_l = 0; float g_l = 0.f;
  if (t < T) { topk_one(sc + ((size_t)t * 8 + wave) * 256, lane, ci, cj, cvalid, e_l, g_l); e_l = __shfl(e_l, lane & 15); g_l = __shfl(g_l, lane & 15); }
  GBuf A, B;
  if (t < T) gl(A, e_l, 0);
  for (; t < T; t += gridDim.x) {
    const int tn = t + gridDim.x < T ? t + gridDim.x : t;
    int e_n; float g_n;
    topk_one(sc + ((size_t)tn * 8 + wave) * 256, lane, ci, cj, cvalid, e_n, g_n); e_n = __shfl(e_n, lane & 15); g_n = __shfl(g_n, lane & 15);
    f2g x2[16];
#pragma unroll
    for (int hsel = 0; hsel < 2; hsel++)
#pragma unroll
      for (int c = 0; c < 2; c++) {
        const u32x4 u = *(const u32x4*)&hm[(size_t)t * 2048 + hsel * 1024 + lane * 16 + c * 8];
#pragma unroll
        for (int i = 0; i < 4; i++) x2[hsel * 8 + c * 4 + i] = f2g{lo2f(u[i]), hi2f(u[i])};
      }
    const float us_l = usc[e_l], vs_l = vsc[e_l];
    f2g acc2[16];
#pragma unroll
    for (int i = 0; i < 16; i++) acc2[i] = f2g{0.f, 0.f};
    auto comp = [&](GBuf& b, int g) {
      float coef[2];
#pragma unroll
      for (int jj = 0; jj < 2; jj++) {
        f2g d2 = {0.f, 0.f};
#pragma unroll
        for (int hsel = 0; hsel < 2; hsel++)
#pragma unroll
          for (int i = 0; i < 4; i++) {
            const f2g lo = __builtin_amdgcn_cvt_pk_f32_fp8((int)b.u[jj][hsel][i], false), hi = __builtin_amdgcn_cvt_pk_f32_fp8((int)b.u[jj][hsel][i], true);
            d2 = lo * x2[hsel * 8 + 2 * i] + d2; d2 = hi * x2[hsel * 8 + 2 * i + 1] + d2;
          }
        const float d = wave_sum(d2[0] + d2[1]) * rdlane(us_l, 2 * g + jj);
        coef[jj] = rdlane(g_l, 2 * g + jj) * rdlane(vs_l, 2 * g + jj) * 0.5f * d * (1.f + erff(d * 0.70710678118654752f));
      }
#pragma unroll
      for (int jj = 0; jj < 2; jj++) {
        const f2g c2 = {coef[jj], coef[jj]};
#pragma unroll
        for (int hsel = 0; hsel < 2; hsel++)
#pragma unroll
          for (int i = 0; i < 4; i++) {
            const f2g lo = __builtin_amdgcn_cvt_pk_f32_fp8((int)b.v[jj][hsel][i], false), hi = __builtin_amdgcn_cvt_pk_f32_fp8((int)b.v[jj][hsel][i], true);
            acc2[hsel * 8 + 2 * i] = c2 * lo + acc2[hsel * 8 + 2 * i]; acc2[hsel * 8 + 2 * i + 1] = c2 * hi + acc2[hsel * 8 + 2 * i + 1];
          }
      }
    };
#pragma unroll 1
    for (int g = 0; g < 8; g += 2) {
      gl(B, e_l, g + 1);
      __builtin_amdgcn_sched_barrier(0);
      comp(A, g);
      __builtin_amdgcn_sched_barrier(0);
      if (g + 2 < 8) gl(A, e_l, g + 2); else gl(A, e_n, 0);
      __builtin_amdgcn_sched_barrier(0);
      comp(B, g + 1);
      __builtin_amdgcn_sched_barrier(0);
    }
    e_l = e_n; g_l = g_n;
#pragma unroll
    for (int hsel = 0; hsel < 2; hsel++)
#pragma unroll
      for (int i = 0; i < 4; i++) {
        const float4 a4 = {acc2[hsel * 8 + 2 * i][0], acc2[hsel * 8 + 2 * i][1], acc2[hsel * 8 + 2 * i + 1][0], acc2[hsel * 8 + 2 * i + 1][1]};
        *(float4*)&red[wave * 2048 + hsel * 1024 + lane * 16 + i * 4] = a4;
      }
    __syncthreads();
    {
      const int n = tid * 4;
      float4 sm = *(float4*)&red[n];
#pragma unroll
      for (int w = 1; w < 8; w++) { const float4 a = *(float4*)&red[w * 2048 + n]; sm.x += a.x; sm.y += a.y; sm.z += a.z; sm.w += a.w; }
      const float4 gt = *(const float4*)&mod[cvec_of(t) * 12288 + 5 * 2048 + n];
      float4 xo = *(float4*)&xbuf[(size_t)t * 2048 + n];
      xo.x += gt.x * sm.x; xo.y += gt.y * sm.y; xo.z += gt.z * sm.z; xo.w += gt.w * sm.w;
      *(float4*)&xbuf[(size_t)t * 2048 + n] = xo;
      if (layer == 0) {
        const float ss = wave_sum(xo.x * xo.x + xo.y * xo.y + xo.z * xo.z + xo.w * xo.w);
        __syncthreads();
        if (lane == 0) red[wave] = ss;
        __syncthreads();
        float tot = 0.f;
#pragma unroll
        for (int w = 0; w < 8; w++) tot += red[w];
        const float rstd = rsqrtf(tot * (1.f / 2048.f) + 1e-6f);
        const float* m1 = (const float*)(p.ws + WS_MOD) + 36864 + cvec_of(t) * 12288;
        const float4 g = *(const float4*)&p.in[IN_NORM1][2048 + n], sc1 = *(const float4*)&m1[2048 + n], sh1 = *(const float4*)&m1[n];
        const u32x2 o = {pack2(xo.x * rstd * g.x * (1.f + sc1.x) + sh1.x, xo.y * rstd * g.y * (1.f + sc1.y) + sh1.y),
                         pack2(xo.z * rstd * g.z * (1.f + sc1.z) + sh1.z, xo.w * rstd * g.w * (1.f + sc1.w) + sh1.w)};
        *(u32x2*)((bf16_t*)(p.ws + WS_HM) + (size_t)t * 2048 + n) = o;
      }
    }
    __syncthreads();
  }
}

DI float2 cmul(float2 a, float2 b) { return make_float2(a.x * b.x - a.y * b.y, a.x * b.y + a.y * b.x); }
DI int PI(int p) { return p + ((p >> 5) << 3); }
DI float2 cadd(float2 a, float2 b) { return make_float2(a.x + b.x, a.y + b.y); }
DI float2 csub(float2 a, float2 b) { return make_float2(a.x - b.x, a.y - b.y); }
DI float2 cmulc(float2 a, float2 b) { return make_float2(a.x * b.x + a.y * b.y, a.y * b.x - a.x * b.y); }
typedef float c2 __attribute__((ext_vector_type(2)));
DI c2 cm(c2 a, c2 t, c2 ts) { return c2{a[0], a[0]} * t + c2{a[1], a[1]} * ts; }
DI void fft_dif(float2* buf_, const float2* tw_, int n) {
  c2* buf = (c2*)buf_; const c2* tw = (const c2*)tw_;
  const int tid = tid_();
  for (int h = n >> 1; h >= 4; h >>= 2) {
    const int q = h >> 1;
    if (q <= 512) {
      const int j = tid & (q - 1), base = ((tid - j) << 2) + j;
      const int a0 = PI(base), a1 = PI(base + q), a2 = PI(base + 2 * q), a3 = PI(base + 3 * q);
      const c2 t = tw[h + j], t2 = tw[q + j], ts = {-t[1], t[0]}, t2s = {-t2[1], t2[0]};
#pragma unroll
      for (int r = 0; r < 4; r++) {
        const int o = r * 2560;
        const c2 x0 = buf[a0 + o], x1 = buf[a1 + o], x2 = buf[a2 + o], x3 = buf[a3 + o];
        const c2 a02 = x0 + x2, s02 = x0 - x2, a13 = x1 + x3, s13 = x1 - x3;
        const c2 u2 = cm(s02, t, ts), m = cm(s13, t, ts), u3 = {m[1], -m[0]};
        buf[a0 + o] = a02 + a13; buf[a1 + o] = cm(a02 - a13, t2, t2s);
        buf[a2 + o] = u2 + u3;   buf[a3 + o] = cm(u2 - u3, t2, t2s);
      }
    } else {
#pragma unroll
      for (int r = 0; r < 4; r++) {
        const int i = tid + r * 512, j = i & (q - 1), base = ((i - j) << 2) + j;
        const int a0 = PI(base), a1 = PI(base + q), a2 = PI(base + 2 * q), a3 = PI(base + 3 * q);
        const c2 t = tw[h + j], t2 = tw[q + j], ts = {-t[1], t[0]}, t2s = {-t2[1], t2[0]};
        const c2 x0 = buf[a0], x1 = buf[a1], x2 = buf[a2], x3 = buf[a3];
        const c2 a02 = x0 + x2, s02 = x0 - x2, a13 = x1 + x3, s13 = x1 - x3;
        const c2 u2 = cm(s02, t, ts), m = cm(s13, t, ts), u3 = {m[1], -m[0]};
        buf[a0] = a02 + a13; buf[a1] = cm(a02 - a13, t2, t2s);
        buf[a2] = u2 + u3;   buf[a3] = cm(u2 - u3, t2, t2s);
      }
    }
    __syncthreads();
  }
#pragma unroll
  for (int r = 0; r < 8; r++) {
    const int a = PI(2 * (tid + r * 512));
    const float4 v = *(const float4*)&buf[a];
    *(float4*)&buf[a] = make_float4(v.x + v.z, v.y + v.w, v.x - v.z, v.y - v.w);
  }
  __syncthreads();
}
DI void fft_dit_inv(float2* buf_, const float2* tw_, int n) {
  c2* buf = (c2*)buf_; const c2* tw = (const c2*)tw_;
  const int tid = tid_();
#pragma unroll
  for (int r = 0; r < 8; r++) {
    const int a = PI(2 * (tid + r * 512));
    const float4 v = *(const float4*)&buf[a];
    *(float4*)&buf[a] = make_float4(v.x + v.z, v.y + v.w, v.x - v.z, v.y - v.w);
  }
  __syncthreads();
  for (int h = 4; h <= (n >> 1); h <<= 2) {
    const int q = h >> 1;
    if (q <= 512) {
      const int j = tid & (q - 1), base = ((tid - j) << 2) + j;
      const int a0 = PI(base), a1 = PI(base + q), a2 = PI(base + 2 * q), a3 = PI(base + 3 * q);
      const c2 tt = tw[h + j], tt2 = tw[q + j];
      const c2 t = {tt[0], -tt[1]}, ts = {tt[1], tt[0]}, t2 = {tt2[0], -tt2[1]}, t2s = {tt2[1], tt2[0]};
#pragma unroll
      for (int r = 0; r < 4; r++) {
        const int o = r * 2560;
        const c2 y0 = buf[a0 + o], y1 = buf[a1 + o], y2 = buf[a2 + o], y3 = buf[a3 + o];
        const c2 v1 = cm(y1, t2, t2s), v3 = cm(y3, t2, t2s);
        const c2 u0 = y0 + v1, u1 = y0 - v1, u2 = y2 + v3, u3 = y2 - v3;
        const c2 w2 = cm(u2, t, ts), m = cm(u3, t, ts), w3 = {-m[1], m[0]};
        buf[a0 + o] = u0 + w2; buf[a2 + o] = u0 - w2; buf[a1 + o] = u1 + w3; buf[a3 + o] = u1 - w3;
      }
    } else {
#pragma unroll
      for (int r = 0; r < 4; r++) {
        const int i = tid + r * 512, j = i & (q - 1), base = ((i - j) << 2) + j;
        const int a0 = PI(base), a1 = PI(base + q), a2 = PI(base + 2 * q), a3 = PI(base + 3 * q);
        const c2 tt = tw[h + j], tt2 = tw[q + j];
        const c2 t = {tt[0], -tt[1]}, ts = {tt[1], tt[0]}, t2 = {tt2[0], -tt2[1]}, t2s = {tt2[1], tt2[0]};
        const c2 y0 = buf[a0], y1 = buf[a1], y2 = buf[a2], y3 = buf[a3];
        const c2 v1 = cm(y1, t2, t2s), v3 = cm(y3, t2, t2s);
        const c2 u0 = y0 + v1, u1 = y0 - v1, u2 = y2 + v3, u3 = y2 - v3;
        const c2 w2 = cm(u2, t, ts), m = cm(u3, t, ts), w3 = {-m[1], m[0]};
        buf[a0] = u0 + w2; buf[a2] = u0 - w2; buf[a1] = u1 + w3; buf[a3] = u1 - w3;
      }
    }
    __syncthreads();
  }
}
DI float conv3_row(const bf16_t* __restrict__ row, int tl, int L, float w0, float w1, float w2, float b) {
  float v = bf2f(row[0]) * w1 + b;
  if (tl > 0) v += bf2f(row[-1]) * w0;
  if (tl < L - 1) v += bf2f(row[1]) * w2;
  return v;
}
template <int L>
DI void hyena_item(const Params& p, int c, float2* buf, const float2* tw, float* sred) {
  constexpr int N = 2 * L, NPOS = (L == 4096) ? 8 : 16;
  constexpr int NTAP = (L == 4096) ? 8 : 1;
  const int tid = tid_();
  const bool act = (L == 4096) ? true : (tid < 256);
  const bf16_t* ut = (const bf16_t*)(p.ws + WS_UT);
  bf16_t* z2t = (bf16_t*)(p.ws + WS_Z2T);
  const float* cw = p.in[IN_OC_CONV]; const float* cb = p.in[IN_OC_CONVB]; const float* bias = p.in[IN_OC_BIAS];
  float hf[2][2][NTAP];
  {
    const bf16_t* filt = (const bf16_t*)(p.ws + WS_FILT) + (L == 4096 ? 256 : 0);
    const float delta = fabsf(-3.0701134573253945f + (float)c * ((-15.350567286626973f + 3.0701134573253945f) / 2047.f));
    float ssq0 = 0.f, ssq1 = 0.f;
#pragma unroll
    for (int i = 0; i < NTAP; i++) {
      const int tt = tid + 512 * i;
      float a00 = 0.f, a01 = 0.f, a10 = 0.f, a11 = 0.f;
      if (tt < L) {
        const float dec = __expf(-((float)tt / (float)(L - 1)) * delta);
        a00 = bf2f(filt[(size_t)(0 * 2048 + c) * 4352 + tt]) * dec; a01 = bf2f(filt[(size_t)(1 * 2048 + c) * 4352 + tt]) * dec;
        a10 = bf2f(filt[(size_t)(2 * 2048 + c) * 4352 + tt]) * dec; a11 = bf2f(filt[(size_t)(3 * 2048 + c) * 4352 + tt]) * dec;
      }
      hf[0][0][i] = a00; hf[0][1][i] = a01; hf[1][0][i] = a10; hf[1][1][i] = a11;
      ssq0 += a00 * a00 + a01 * a01; ssq1 += a10 * a10 + a11 * a11;
    }
    __syncthreads();
    ssq0 = wave_sum(ssq0); ssq1 = wave_sum(ssq1);
    if ((tid & 63) == 0) { sred[(tid >> 6) * 2] = ssq0; sred[(tid >> 6) * 2 + 1] = ssq1; }
    __syncthreads();
    float t0 = 0.f, t1 = 0.f;
#pragma unroll
    for (int w = 0; w < 8; w++) { t0 += sred[w * 2]; t1 += sred[w * 2 + 1]; }
    const float sc0 = rsqrtf(t0 + 1e-12f), sc1 = rsqrtf(t1 + 1e-12f);
#pragma unroll
    for (int i = 0; i < NTAP; i++) { hf[0][0][i] *= sc0; hf[0][1][i] *= sc0; hf[1][0][i] *= sc1; hf[1][1][i] *= sc1; }
  }
  auto tok_of = [&](int i, int m) -> size_t {
    if (L == 4096) return (size_t)TP + (size_t)m * 4096 + tid + 512 * i;
    return (size_t)(2 * i + m) * 256 + tid;
  };
  auto tl_of = [&](int i) -> int { return (L == 4096) ? tid + 512 * i : tid; };
  float zin[NPOS][2];
  const float inv_n = 1.f / (float)N;
#pragma unroll
  for (int o = 0; o < 2; o++) {
    __syncthreads();
#pragma unroll
    for (int i = 0; i < NTAP; i++) {
      const int tt = tid + 512 * i;
      if (tt < L) {
        for (int seg = 0; seg < 8192 / N; seg++) {
          buf[PI(seg * N + tt)] = make_float2(hf[o][0][i], 0.f);
          if (tt >= 1) buf[PI(seg * N + N - tt)] = make_float2(hf[o][1][i], 0.f); else buf[PI(seg * N + L)] = make_float2(0.f, 0.f);
        }
      }
    }
    __syncthreads();
    fft_dif(buf, tw, N);
    float2 F[16];
#pragma unroll
    for (int i = 0; i < 16; i++) F[i] = buf[PI(tid + 512 * i)];
    __syncthreads();
    if (o == 0) {
      const float w0 = cw[4096 + c], w1 = cw[6144 + 4096 + c], w2 = cw[12288 + 4096 + c], bb = cb[4096 + c];
#pragma unroll
      for (int i = 0; i < NPOS; i++)
#pragma unroll
        for (int m = 0; m < 2; m++)
          zin[i][m] = act ? conv3_row(ut + (size_t)(4096 + c) * T + tok_of(i, m), tl_of(i), L, w0, w1, w2, bb) : 0.f;
    }
#pragma unroll
    for (int i = 0; i < 16; i++) {
      const int pp = tid + 512 * i;
      float2 val = make_float2(0.f, 0.f);
      if (L == 4096) { if (i < 8) val = make_float2(zin[i < 8 ? i : 0][0], zin[i < 8 ? i : 0][1]); }
      else { if (act) val = make_float2(zin[i % NPOS][0], zin[i % NPOS][1]); }
      buf[PI(pp)] = val;
    }
    __syncthreads();
    fft_dif(buf, tw, N);
#pragma unroll
    for (int i = 0; i < 16; i++) { const int pp = PI(tid + 512 * i); buf[pp] = cmul(buf[pp], F[i]); }
    __syncthreads();
    fft_dit_inv(buf, tw, N);
    {
      const int gcol = o * 2048 + c;
      const float w0 = cw[gcol], w1 = cw[6144 + gcol], w2 = cw[12288 + gcol], bb = cb[gcol];
      const float bo = bias[o * 2048 + c];
#pragma unroll
      for (int i = 0; i < NPOS; i++) {
        const int pp = (L == 4096) ? tid + 512 * i : i * 512 + tid;
        const float2 cv = buf[PI(pp)];
#pragma unroll
        for (int m = 0; m < 2; m++) {
          if (act) {
            const float gate = conv3_row(ut + (size_t)gcol * T + tok_of(i, m), tl_of(i), L, w0, w1, w2, bb);
            const float conv = (m == 0 ? cv.x : cv.y) * inv_n;
            zin[i][m] = gate * (conv + bo * zin[i][m]);
          }
        }
      }
    }
  }
  if (act) {
#pragma unroll
    for (int i = 0; i < NPOS; i++)
#pragma unroll
      for (int m = 0; m < 2; m++) z2t[(size_t)c * T + tok_of(i, m)] = f2bf(zin[i][m]);
  }
}
template <int L>
DI void hyena_item_mfma(const Params& p, int c, char* lds, float* sred) {
  constexpr int NTAP = (L == 4096) ? 8 : 1;
  constexpr int GN = 2 * L, GS = GN + 32, RS = 264;
  const int tid = tid_(), lane = tid & 63, wave = tid >> 6, r32 = lane & 31, h = lane >> 5;
  const size_t tokbase = (L == 4096) ? (size_t)TP : 0;
  bf16_t* G = (bf16_t*)lds;
  bf16_t* ub = (bf16_t*)(lds + 66560); bf16_t* zb = ub + 32 * RS; bf16_t* x1b = zb + 32 * RS; bf16_t* x2b = x1b + 32 * RS; bf16_t* zeros = x2b + 32 * RS;
  const bf16_t* ut = (const bf16_t*)(p.ws + WS_UT);
  bf16_t* z2t = (bf16_t*)(p.ws + WS_Z2T);
  const float* cw = p.in[IN_OC_CONV]; const float* cb = p.in[IN_OC_CONVB]; const float* bias = p.in[IN_OC_BIAS];
  float hf[2][2][NTAP];
  {
    const bf16_t* filt = (const bf16_t*)(p.ws + WS_FILT) + (L == 4096 ? 256 : 0);
    const float delta = fabsf(-3.0701134573253945f + (float)c * ((-15.350567286626973f + 3.0701134573253945f) / 2047.f));
    float ssq0 = 0.f, ssq1 = 0.f;
#pragma unroll
    for (int i = 0; i < NTAP; i++) {
      const int tt = tid + 512 * i;
      float a00 = 0.f, a01 = 0.f, a10 = 0.f, a11 = 0.f;
      if (tt < L) {
        const float dec = __expf(-((float)tt / (float)(L - 1)) * delta);
        a00 = bf2f(filt[(size_t)(0 * 2048 + c) * 4352 + tt]) * dec; a01 = bf2f(filt[(size_t)(1 * 2048 + c) * 4352 + tt]) * dec;
        a10 = bf2f(filt[(size_t)(2 * 2048 + c) * 4352 + tt]) * dec; a11 = bf2f(filt[(size_t)(3 * 2048 + c) * 4352 + tt]) * dec;
      }
      hf[0][0][i] = a00; hf[0][1][i] = a01; hf[1][0][i] = a10; hf[1][1][i] = a11;
      ssq0 += a00 * a00 + a01 * a01; ssq1 += a10 * a10 + a11 * a11;
    }
    __syncthreads();
    ssq0 = wave_sum(ssq0); ssq1 = wave_sum(ssq1);
    if (lane == 0) { sred[wave * 2] = ssq0; sred[wave * 2 + 1] = ssq1; }
    __syncthreads();
    float t0 = 0.f, t1 = 0.f;
#pragma unroll
    for (int w = 0; w < 8; w++) { t0 += sred[w * 2]; t1 += sred[w * 2 + 1]; }
    const float sc0 = rsqrtf(t0 + 1e-12f), sc1 = rsqrtf(t1 + 1e-12f);
#pragma unroll
    for (int i = 0; i < NTAP; i++) { hf[0][0][i] *= sc0; hf[0][1][i] *= sc0; hf[1][0][i] *= sc1; hf[1][1][i] *= sc1; }
  }
#pragma unroll
  for (int o = 0; o < 2; o++) {
    bf16_t* c0 = G + (o * 2 + 0) * GS; bf16_t* c1 = G + (o * 2 + 1) * GS;
#pragma unroll
    for (int i = 0; i < NTAP; i++) {
      const int tt = tid + 512 * i;
      if (tt < L) {
        const bf16_t f = f2bf(hf[o][0][i]), bw = f2bf(hf[o][1][i]);
        const int i_f = L - 1 - tt;
        c0[i_f] = f; if (i_f >= 1) c1[i_f - 1] = f;
        if (tt >= 1) { const int i_b = L - 1 + tt; c0[i_b] = bw; c1[i_b - 1] = bw; }
      }
    }
    if (tid == 0) { c0[2 * L - 1] = 0; c1[2 * L - 2] = 0; c1[2 * L - 1] = 0; }
  }
  if (tid < 128) ((unsigned*)zeros)[tid] = 0u;
  auto load_conv = [&](int rowsel, bf16_t* dst) {
    const bf16_t* src = ut + (size_t)rowsel * T + tokbase + 16 * tid;
    float f[18];
    unpack8(*(const u32x4*)src, f + 1); unpack8(*(const u32x4*)(src + 8), f + 9);
    const int pos = (16 * tid) & (L - 1);
    f[0] = pos > 0 ? bf2f(src[-1]) : 0.f; f[17] = pos + 16 < L ? bf2f(src[16]) : 0.f;
    const float w0 = cw[rowsel], w1 = cw[6144 + rowsel], w2 = cw[12288 + rowsel], bb = cb[rowsel];
    float o[16];
#pragma unroll
    for (int e = 0; e < 16; e++) o[e] = f[e] * w0 + f[e + 1] * w1 + f[e + 2] * w2 + bb;
    const u32x4 o0 = {pack2(o[0], o[1]), pack2(o[2], o[3]), pack2(o[4], o[5]), pack2(o[6], o[7])};
    const u32x4 o1 = {pack2(o[8], o[9]), pack2(o[10], o[11]), pack2(o[12], o[13]), pack2(o[14], o[15])};
    bf16_t* d = dst + (tid >> 4) * RS + (tid & 15) * 16;
    *(u32x4*)d = o0; *(u32x4*)(d + 8) = o1;
  };
  load_conv(4096 + c, ub); load_conv(c, x1b); load_conv(2048 + c, x2b);
  __syncthreads();
  auto conv = [&](int o, const bf16_t* bsrc) -> f32x16 {
    f32x16 acc;
#pragma unroll
    for (int r = 0; r < 16; r++) acc[r] = 0.f;
    const int par = (r32 & 1) ^ 1;
    const unsigned* gc = (const unsigned*)(G + (o * 2 + par) * GS);
    const int i00 = L - 1 - 32 * wave - r32 + 8 * h;
    u32x4 cur[16];
    auto loadB = [&]() {
#pragma unroll
      for (int kb = 0; kb < 16; kb++) cur[kb] = *(const u32x4*)(bsrc + r32 * RS + 8 * h + 16 * kb);
    };
    auto mm = [&](int m) {
      const unsigned* gp = gc + ((i00 - 256 * m - par) >> 1);
#pragma unroll
      for (int kb = 0; kb < 16; kb++) {
        const u32x4 av = {gp[8 * kb], gp[8 * kb + 1], gp[8 * kb + 2], gp[8 * kb + 3]};
        acc = __builtin_amdgcn_mfma_f32_32x32x16_bf16(__builtin_bit_cast(bf16x8, av), __builtin_bit_cast(bf16x8, cur[kb]), acc, 0, 0, 0);
      }
    };
    loadB(); mm(0);
    if constexpr (L == 4096) {
#pragma unroll 1
      for (int m = 1; m <= 15; m++) {
#pragma unroll
        for (int kb = 0; kb < 16; kb++)
#pragma unroll
          for (int e = 0; e < 4; e++) cur[kb][e] = (unsigned)__builtin_amdgcn_update_dpp(0, (int)cur[kb][e], 0x111, 0xf, 0xf, true);
        mm(m);
      }
      loadB();
#pragma unroll 1
      for (int m = -1; m >= -15; m--) {
#pragma unroll
        for (int kb = 0; kb < 16; kb++)
#pragma unroll
          for (int e = 0; e < 4; e++) cur[kb][e] = (unsigned)__builtin_amdgcn_update_dpp(0, (int)cur[kb][e], 0x101, 0xf, 0xf, true);
        mm(m);
      }
    }
    return acc;
  };
  auto gate = [&](const f32x16& acc, const bf16_t* uin, const bf16_t* gt, float bo, bf16_t* dst) {
#pragma unroll
    for (int k = 0; k < 4; k++) {
      const int idx = r32 * RS + 32 * wave + 8 * k + 4 * h;
      const u32x2 uu = *(const u32x2*)(uin + idx), gg = *(const u32x2*)(gt + idx);
      const float u0 = lo2f(uu[0]), u1 = hi2f(uu[0]), u2 = lo2f(uu[1]), u3 = hi2f(uu[1]);
      const float g0 = lo2f(gg[0]), g1 = hi2f(gg[0]), g2 = lo2f(gg[1]), g3 = hi2f(gg[1]);
      const u32x2 ov = {pack2(g0 * (acc[4 * k] + bo * u0), g1 * (acc[4 * k + 1] + bo * u1)), pack2(g2 * (acc[4 * k + 2] + bo * u2), g3 * (acc[4 * k + 3] + bo * u3))};
      *(u32x2*)(dst + idx) = ov;
    }
  };
  { const f32x16 a0 = conv(0, ub); gate(a0, ub, x1b, bias[c], zb); }
  __syncthreads();
  { const f32x16 a1 = conv(1, zb); gate(a1, zb, x2b, bias[2048 + c], ub); }
  __syncthreads();
  { bf16_t* dstp = z2t + (size_t)c * T + tokbase + 16 * tid;
    const bf16_t* sp = ub + (tid >> 4) * RS + (tid & 15) * 16;
    *(u32x4*)dstp = *(const u32x4*)sp; *(u32x4*)(dstp + 8) = *(const u32x4*)(sp + 8); }
}
DI void phase_hyena_mfma(const Params& p, char* lds) {
  __shared__ float sred_m[32];
  for (int it = blockIdx.x; it < 4096; it += gridDim.x) {
    if (it < 2048) hyena_item_mfma<4096>(p, it, lds, sred_m);
    else hyena_item_mfma<256>(p, it - 2048, lds, sred_m);
  }
}
DI void phase_hyena(const Params& p, char* lds) {
  float2* buf = (float2*)lds; float2* tw = (float2*)(lds + 81920);
  __shared__ float sred_s[32 + 256];
  for (int k = tid_(); k < 8192; k += NTH) {
    if (k >= 1) { const int half = 1 << (31 - __clz(k)); float s, c; sincospif((float)(k - half) / (float)half, &s, &c); tw[k] = make_float2(c, -s); }
  }
  __syncthreads();
  for (int it = blockIdx.x; it < 4096; it += gridDim.x) {
    if (it < 2048) hyena_item<4096>(p, it, buf, tw, sred_s);
    else hyena_item<256>(p, it - 2048, buf, tw, sred_s);
  }
}
DI void phase_transpose_z2(const Params& p, char* lds) {
  const bf16_t* src = (const bf16_t*)(p.ws + WS_Z2T); bf16_t* dst = (bf16_t*)(p.ws + WS_HM);
  bf16_t* tile = (bf16_t*)lds;
  const int tid = tid_();
  for (int tI = blockIdx.x; tI < 32 * 256; tI += gridDim.x) {
    const int c0 = (tI >> 8) * 64, t0 = (tI & 255) * 64;
    { const int r = tid >> 3, ch = tid & 7;
      *(u32x4*)&tile[r * 72 + ch * 8] = *(const u32x4*)&src[(size_t)(c0 + r) * T + t0 + ch * 8]; }
    __syncthreads();
    { const int tt = tid >> 3, cc = tid & 7;
      unsigned short v[8];
#pragma unroll
      for (int j = 0; j < 8; j++) v[j] = tile[(cc * 8 + j) * 72 + tt];
      u32x4 o = {(unsigned)v[0] | ((unsigned)v[1] << 16), (unsigned)v[2] | ((unsigned)v[3] << 16), (unsigned)v[4] | ((unsigned)v[5] << 16), (unsigned)v[6] | ((unsigned)v[7] << 16)};
      *(u32x4*)&dst[(size_t)(t0 + tt) * 2048 + c0 + cc * 8] = o; }
    __syncthreads();
  }
}

DI void peer_block(const Params& p, int layer, const XcdBarrier& xb, char* lds) {
  const float* mod = (const float*)(p.ws + WS_MOD) + layer * 36864;
  bf16_t* hm = (bf16_t*)(p.ws + WS_HM);
  phase_norm(p.out, p.out + (size_t)TP * 2048, p.in[IN_NORM2] + layer * 2048, mod, 3 * 2048, 4 * 2048, hm);
  xcd_barrier(xb);
  { EpiBF16 e{(bf16_t*)(p.ws + WS_PQ), 2048};
    gemm_full<256>(hm, 2048, (const bf16_t*)(p.ws + WS_WT_Q) + (size_t)layer * 2048 * 2048, 2048, T, 2048, 2048, e, lds); }
  xcd_barrier(xb);
  {
    EpiF32 e{(float*)(p.ws + WS_SC), 2048};
    const bf16_t* q = (const bf16_t*)(p.ws + WS_PQ); const bf16_t* keys = (const bf16_t*)(p.ws + WS_KEYS) + (size_t)layer * 2048 * 128;
    for (int tile = blockIdx.x; tile < 64 * 16; tile += gridDim.x) {
      const int g = tile & 15, mt = tile >> 4;
      gemm_tile<128>(q + g * 128, 2048, keys, 128, mt * 256, g * 128, 2048, 128, e, lds);
    }
  }
  xcd_barrier(xb);
  phase_gather(p, layer, lds);
  xcd_barrier(xb);
}

__global__ void __launch_bounds__(NTH) fwd_megakernel(Params p) {
  cg::grid_group grid = cg::this_grid();
  __shared__ __attribute__((aligned(16))) char lds[LDS_BYTES];
  float* mod = (float*)(p.ws + WS_MOD);
  bf16_t* hm = (bf16_t*)(p.ws + WS_HM);

  __shared__ uint4 xb_words;
  unsigned* bar = (unsigned*)(p.ws + WS_BAR);
  if (tid_() == 0) xb_words = make_uint4(0u, 0u, 0u, 0u);
  if (blockIdx.x == 0) for (int i = tid_(); i < XCD_BAR_WORDS; i += NTH) bar[i] = 0u;
  transpose_tiles(p.in[IN_EW_IN], (bf16_t*)(p.ws + WS_WT_IN0), 2048, ZC, (float*)lds);
  for (int d = 0; d < 2; d++) {
    transpose_tiles(p.in[IN_EA_WU] + d * 65536, (bf16_t*)(p.ws + WS_WU_T) + d * 65536, 64, 1024, (float*)lds);
    transpose_tiles(p.in[IN_EA_AU] + d * 65536, (bf16_t*)(p.ws + WS_AU_T) + d * 65536, 64, 1024, (float*)lds);
  }
  transpose_tiles(p.in[IN_EA_GU], (bf16_t*)(p.ws + WS_GU_T), 128, 1024, (float*)lds);
  convert_bf16(p.in[IN_PEER_KEYS], (bf16_t*)(p.ws + WS_KEYS), (size_t)2 * 2048 * 128 / 8);
  phase_mod_partial(p);
  phase_hdn2(p);
  grid.sync();
  const XcdBarrier xb = xcd_barrier_post(bar, (volatile LAS unsigned*)&xb_words);
  phase_mod_reduce(p);
  xcd_barrier(xb);
  phase_norm(p.in[IN_X_PROMPT], p.in[IN_X_SAMPLE], p.in[IN_NORM1], mod, 0, 2048, hm);
  xcd_barrier(xb);
  { EpiBF16 e{(bf16_t*)(p.ws + WS_Z0), ZC};
    gemm_full<256>(hm, 2048, (const bf16_t*)(p.ws + WS_WT_IN0), 2048, T, ZC, 2048, e, lds); }
  xcd_barrier(xb);
  phase_prep0(p, lds);
  xcd_barrier(xb);
  {
    const bf16_t* Qb = (const bf16_t*)(p.ws + WS_QB); bf16_t* A2 = (bf16_t*)(p.ws + WS_A2);
    for (int it = blockIdx.x; it < 512; it += gridDim.x) {
      __syncthreads();
      size_t row0, kvoff; int h, seq; const bf16_t *Kb, *Vb;
      if (it < 256) {
        const int b = it >> 7, qb = it & 15; h = (it >> 4) & 7;
        row0 = (size_t)TP + (size_t)b * 4096 + qb * 256; kvoff = (size_t)b * SKV_S * 256; seq = SKV_S;
        Kb = (const bf16_t*)(p.ws + WS_KBS); Vb = (const bf16_t*)(p.ws + WS_VBS);
      } else {
        const int i = it - 256, b = i >> 3; h = i & 7;
        row0 = (size_t)b * 256; kvoff = row0 * 256; seq = 256;
        Kb = (const bf16_t*)(p.ws + WS_KBP); Vb = (const bf16_t*)(p.ws + WS_VBP);
      }
      attn_dense_body<1024, 256, 2048>(Qb + row0 * 1024 + h * 128, Kb + kvoff + (h >> 2) * 128, Vb + kvoff + (h >> 2) * 128,
                                       A2 + row0 * 2048 + 1024 + h * 128, seq, lds);
    }
    __syncthreads();
    const bf16_t* actA = (const bf16_t*)(p.ws + WS_ACTA);
    for (int d = 0; d < 2; d++) {
      EpiW ew{(float*)(p.ws + WS_W), p.in[IN_EA_W0], d};
      gemm_full<256>(actA + d * 64, 384, (const bf16_t*)(p.ws + WS_WU_T) + d * 65536, 64, T, 1024, 64, ew, lds);
      EpiA ea{(bf16_t*)(p.ws + WS_UB), p.in[IN_EA_A0], d};
      gemm_full<256>(actA + 128 + d * 64, 384, (const bf16_t*)(p.ws + WS_AU_T) + d * 65536, 64, T, 1024, 64, ea, lds);
    }
    EpiBF16 eg{(bf16_t*)(p.ws + WS_G), 1024};
    gemm_full<256>(actA + 256, 384, (const bf16_t*)(p.ws + WS_GU_T), 128, T, 1024, 128, eg, lds);
  }
  xcd_barrier(xb);
  phase_fixa(p);
  xcd_barrier(xb);
  phase_scan(p, lds);
  xcd_barrier(xb);
  phase_post0(p);
  xcd_barrier(xb);
  { EpiRes e{p.in[IN_X_PROMPT], p.in[IN_X_SAMPLE], mod + 2 * 2048, p.out};
    gemm_full<256>((const bf16_t*)(p.ws + WS_A2), 2048, (const bf16_t*)(p.ws + WS_WT_OUT0), 2048, T, 2048, 2048, e, lds); }
  xcd_barrier(xb);
  peer_block(p, 0, xb, lds);
  { EpiBF16 e{(bf16_t*)(p.ws + WS_UT), (size_t)T};
    gemm_full<256>((const bf16_t*)(p.ws + WS_WT_IN1), 2048, hm, 2048, 6144, T, 2048, e, lds); }
  { EpiBF16 e{(bf16_t*)(p.ws + WS_FILT), 4352};
    gemm_full<256>((const bf16_t*)(p.ws + WS_FW3T), 64, (const bf16_t*)(p.ws + WS_HDN2B), 64, 8192, 4352, 64, e, lds); }
  xcd_barrier(xb);
  phase_hyena_mfma(p, lds);
  xcd_barrier(xb);
  phase_transpose_z2(p, lds);
  xcd_barrier(xb);
  { EpiRes e{p.out, p.out + (size_t)TP * 2048, mod + 36864 + 2 * 2048, p.out};
    gemm_full<256>(hm, 2048, (const bf16_t*)(p.ws + WS_WT_OUT1), 2048, T, 2048, 2048, e, lds); }
  xcd_barrier(xb);
  peer_block(p, 1, xb, lds);
}

extern "C" void kernel_launch(void* const* d_in, const int* in_sizes, int n_in, void* d_out, int out_size, void* d_ws, size_t ws_size, hipStream_t stream) {
  static int grid_blocks = 0;
  if (!grid_blocks) {
    int dev = 0, cus = 0, per_cu = 0;
    hipGetDevice(&dev);
    hipDeviceGetAttribute(&cus, hipDeviceAttributeMultiprocessorCount, dev);
    hipOccupancyMaxActiveBlocksPerMultiprocessor(&per_cu, fwd_megakernel, NTH, 0);
    if (per_cu < 1) per_cu = 1;
    if (per_cu > 1) per_cu = 1;
    grid_blocks = cus * per_cu;
  }
  if (n_in != N_IN || ws_size < WS_END2) { fprintf(stderr, "kernel_launch: bad n_in %d or ws_size %zu < %zu\n", n_in, ws_size, (size_t)WS_END); return; }
  Params p{};
  for (int i = 0; i < N_IN; i++) p.in[i] = (const float*)d_in[i];
  p.out = (float*)d_out; p.ws = (char*)d_ws;
  void* args[] = {&p};
  hipError_t e = hipLaunchCooperativeKernel((void*)fwd_megakernel, dim3(grid_blocks), dim3(NTH), args, 0, stream);
  if (e != hipSuccess) fprintf(stderr, "cooperative launch failed: %s (grid %d)\n", hipGetErrorString(e), grid_blocks);
}
```

```cpp
#include <hip/hip_runtime.h>
#include <hip/hip_cooperative_groups.h>
#include <stdint.h>
#include <stdio.h>
namespace cg = cooperative_groups;

#define DI __device__ __forceinline__
typedef unsigned short bf16_t;
using bf16x8 = __attribute__((ext_vector_type(8))) short;
using s16x4  = __attribute__((ext_vector_type(4))) short;
using f32x16 = __attribute__((ext_vector_type(16))) float;
using u32x4  = __attribute__((ext_vector_type(4))) unsigned;
using u32x2  = __attribute__((ext_vector_type(2))) unsigned;

constexpr int NTH = 512;
constexpr int T = 16384, TP = 8192, DM = 2048;
constexpr int ZC = 4992;
constexpr int SKV_S = 4608;

enum { IN_X_PROMPT = 0, IN_X_SAMPLE, IN_CACHE_K, IN_CACHE_V, IN_STATE_A, IN_C, IN_C_CTX, IN_MOD_W, IN_MOD_B, IN_NORM1, IN_NORM2,
       IN_EW_IN, IN_EA_CONV, IN_EA_W0, IN_EA_WU, IN_EA_A0, IN_EA_AU, IN_EA_GU, IN_EA_KK, IN_EA_KA, IN_EA_RK, IN_EA_LNW, IN_EA_LNB,
       IN_EB_QN, IN_EB_KN, IN_EW_OUT,
       IN_OW_IN, IN_OC_CONV, IN_OC_CONVB, IN_OC_FW1, IN_OC_FB1, IN_OC_FREQ, IN_OC_FW2, IN_OC_FB2, IN_OC_FW3, IN_OC_BIAS, IN_OW_OUT,
       IN_PEER_WQ, IN_PEER_KEYS, IN_PEER_U, IN_PEER_V, N_IN };

struct Params { const float* in[N_IN]; float* out; char* ws; };

constexpr size_t OUT_Y = 0, OUT_NK = 33554432, OUT_NV = 35651584, OUT_NS = 37748736;

constexpr size_t al256(size_t x) { return (x + 255) / 256 * 256; }
constexpr size_t WS_WT_IN0  = 0;
constexpr size_t WS_WT_OUT0 = WS_WT_IN0 + (size_t)ZC * 2048 * 2;
constexpr size_t WS_WT_IN1  = WS_WT_OUT0 + (size_t)2048 * 2048 * 2;
constexpr size_t WS_WT_OUT1 = WS_WT_IN1 + (size_t)6144 * 2048 * 2;
constexpr size_t WS_WT_Q    = WS_WT_OUT1 + (size_t)2048 * 2048 * 2;
constexpr size_t WS_KEYS    = WS_WT_Q + (size_t)2 * 2048 * 2048 * 2;
constexpr size_t WS_WU_T    = WS_KEYS + (size_t)2 * 2048 * 128 * 2;
constexpr size_t WS_AU_T    = WS_WU_T + 262144;
constexpr size_t WS_GU_T    = WS_AU_T + 262144;
constexpr size_t WS_MPART   = WS_GU_T + 262144;
constexpr size_t WS_MOD     = WS_MPART + (size_t)2 * 64 * 3 * 12288 * 4;
constexpr size_t WS_HDN2    = WS_MOD + (size_t)2 * 3 * 12288 * 4;
constexpr size_t WS_FW3T    = al256(WS_HDN2 + (size_t)4352 * 64 * 4);
constexpr size_t WS_HDN2B   = WS_FW3T + (size_t)8192 * 64 * 2;
constexpr size_t WS_BAR     = al256(WS_HDN2B + (size_t)4352 * 64 * 2);
constexpr size_t WS_HM      = al256(WS_BAR + 16384);
constexpr size_t WS_Z0      = WS_HM + (size_t)T * 2048 * 2;
constexpr size_t WS_QB      = WS_Z0 + (size_t)T * ZC * 2;
constexpr size_t WS_KBP     = WS_QB + (size_t)T * 1024 * 2;
constexpr size_t WS_VBP     = WS_KBP + (size_t)8192 * 256 * 2;
constexpr size_t WS_KBS     = WS_VBP + (size_t)8192 * 256 * 2;
constexpr size_t WS_VBS     = WS_KBS + (size_t)2 * SKV_S * 256 * 2;
constexpr size_t WS_ACTA    = WS_VBS + (size_t)2 * SKV_S * 256 * 2;
constexpr size_t WS_BON     = WS_ACTA + (size_t)T * 384 * 2;
constexpr size_t WS_RW      = WS_BON + (size_t)T * 16 * 4;
constexpr size_t WS_R       = WS_RW;
constexpr size_t WS_KK      = WS_R + (size_t)T * 1024 * 4;
constexpr size_t WS_V       = WS_KK + (size_t)T * 1024 * 4;
constexpr size_t WS_W       = WS_V + (size_t)T * 1024 * 4;
constexpr size_t WS_KKA     = WS_W + (size_t)T * 2048 * 4;
constexpr size_t WS_KT      = WS_KKA + (size_t)T * 2048 * 4;
constexpr size_t WS_END     = WS_KT + (size_t)T * 2048 * 4;
constexpr size_t WS_G       = WS_Z0;
constexpr size_t WS_A2      = WS_Z0 + (size_t)T * 1024 * 4;
static_assert(WS_A2 + (size_t)T * 2048 * 2 <= WS_QB, "overlay");
constexpr size_t WS_UB      = WS_END;
constexpr size_t WS_END2    = WS_UB + (size_t)2 * 16384 * 2048;
constexpr size_t WS_VB      = WS_Z0 + (size_t)T * 1024 * 4 + (size_t)T * 2048 * 2;
static_assert(WS_VB + (size_t)2 * 16384 * 2048 <= WS_BON, "v tables overlay");
constexpr size_t WS_SC      = WS_RW;
constexpr size_t WS_UT      = WS_SC;
constexpr size_t WS_IDX     = WS_SC + (size_t)6144 * T * 2;
constexpr size_t WS_GATE    = WS_IDX + (size_t)T * 128 * 4;
constexpr size_t WS_FILT    = WS_GATE + (size_t)T * 128 * 4;
static_assert(WS_FILT + (size_t)8192 * 4352 * 2 <= WS_END, "overlay2");
constexpr size_t WS_TSC     = WS_MPART;
constexpr size_t WS_PQ      = WS_Z0;
constexpr size_t WS_Z2T     = WS_Z0;
static_assert(WS_END2 <= (size_t)1024 * 1024 * 1024, "ws budget");

constexpr int LDS_BYTES = 147456;

DI int tid_() { int t = __builtin_amdgcn_workitem_id_x(); asm volatile("" : "+v"(t)); return t; }
DI float bf2f(bf16_t b) { return __uint_as_float(((unsigned)b) << 16); }
DI bf16_t f2bf(float x) { unsigned u = __float_as_uint(x); u += 0x7fffu + ((u >> 16) & 1u); return (bf16_t)(u >> 16); }
DI unsigned pack2(float lo, float hi) { return (unsigned)f2bf(lo) | ((unsigned)f2bf(hi) << 16); }
DI float lo2f(unsigned u) { return __uint_as_float(u << 16); }
DI float hi2f(unsigned u) { return __uint_as_float(u & 0xffff0000u); }
DI int crow(int r, int h) { return (r & 3) + 8 * (r >> 2) + 4 * h; }
template <int CTRL> DI float dppf(float x) { return __int_as_float(__builtin_amdgcn_update_dpp(0, __float_as_int(x), CTRL, 0xf, 0xf, false)); }
DI float rdlane(float v, int l) { return __int_as_float(__builtin_amdgcn_readlane(__float_as_int(v), l)); }
DI float wave_sum(float v) {
  v += dppf<0xB1>(v); v += dppf<0x4E>(v); v += dppf<0x141>(v); v += dppf<0x140>(v);
  return (rdlane(v, 0) + rdlane(v, 16)) + (rdlane(v, 32) + rdlane(v, 48));
}
DI float wave_max(float v) {
  v = fmaxf(v, dppf<0xB1>(v)); v = fmaxf(v, dppf<0x4E>(v)); v = fmaxf(v, dppf<0x141>(v)); v = fmaxf(v, dppf<0x140>(v));
  return fmaxf(fmaxf(rdlane(v, 0), rdlane(v, 16)), fmaxf(rdlane(v, 32), rdlane(v, 48)));
}
DI float sigmoidf_(float x) { return __builtin_amdgcn_rcpf(1.f + __expf(-x)); }
DI int cvec_of(int t) { return t < TP ? 0 : 1 + ((t - TP) >> 12); }
template <int LPR> DI float row_reduce(float x) {
  x += dppf<0xB1>(x);
  x += dppf<0x4E>(x);
  if (LPR == 8) { x += dppf<0x141>(x); }
  if (LPR == 16) { x += dppf<0x124>(x); x += dppf<0x128>(x); }
  return x;
}
DI void unpack8(u32x4 u, float* f) {
  f[0] = lo2f(u[0]); f[1] = hi2f(u[0]); f[2] = lo2f(u[1]); f[3] = hi2f(u[1]);
  f[4] = lo2f(u[2]); f[5] = hi2f(u[2]); f[6] = lo2f(u[3]); f[7] = hi2f(u[3]);
}

#define XB_TMO      128
#define XB_XCNT(j)  (256  + 64 * (j))
#define XB_XSUB(j)  (1280 + 64 * (j))
#define XB_XGEN(j)  (2304 + 64 * (j))
#define XB_TOP      3328
#define XB_TOPGEN   3392
#define XCD_BAR_WORDS 3456
#define XB_SPIN_CAP (1u << 18)
#define LAS __attribute__((address_space(3)))
DI unsigned xb_ld(unsigned* p)              { return __hip_atomic_load(p, __ATOMIC_RELAXED, __HIP_MEMORY_SCOPE_AGENT); }
DI unsigned xb_add(unsigned* p, unsigned v) { return __hip_atomic_fetch_add(p, v, __ATOMIC_RELAXED, __HIP_MEMORY_SCOPE_AGENT); }
DI unsigned xb_xcc_id() { return (unsigned)__builtin_amdgcn_s_getreg((3 << 11) | 20) & 0xFu; }
#define XB_SPIN(cond, bar) do { unsigned _sp = 0; while (cond) { __builtin_amdgcn_s_sleep(1); \
    if ((++_sp & 255u) == 0u) { if (xb_ld(&(bar)[XB_TMO])) break; if (_sp > XB_SPIN_CAP) { atomicAdd(&(bar)[XB_TMO], 1u); break; } } } } while (0)
struct XcdBarrier { unsigned* bar; unsigned x; volatile LAS unsigned* st; };
DI XcdBarrier xcd_barrier_post(unsigned* bar, volatile LAS unsigned* st) {
  XcdBarrier b; b.bar = bar; b.x = xb_xcc_id(); b.st = st;
  if (__builtin_amdgcn_workitem_id_x() == 0) (void)xb_add(&bar[XB_XCNT(b.x)], 1u);
  return b;
}
DI void xcd_barrier_complete(unsigned* bar, unsigned x, unsigned& nloc, unsigned& nx) {
  const unsigned G = gridDim.x * gridDim.y * gridDim.z;
  unsigned sum, cnt, mine, sp = 0u;
  for (;;) {
    sum = 0u; cnt = 0u; mine = 0u;
#pragma unroll
    for (unsigned j = 0; j < 16; ++j) { const unsigned c = xb_ld(&bar[XB_XCNT(j)]); sum += c; cnt += (c > 0u) ? 1u : 0u; mine = (j == x) ? c : mine; }
    if (sum == G) break;
    __builtin_amdgcn_s_sleep(1);
    if ((++sp & 255u) == 0u) { if (xb_ld(&bar[XB_TMO])) break; if (sp > XB_SPIN_CAP) { atomicAdd(&bar[XB_TMO], 1u); break; } }
  }
  nloc = mine > 0u ? mine : 1u; nx = cnt > 0u ? cnt : 1u;
}
DI void xcd_barrier(const XcdBarrier& b) {
  asm volatile("s_waitcnt vmcnt(0)" ::: "memory");
  __syncthreads();
  if (__builtin_amdgcn_workitem_id_x() == 0) {
    unsigned* bar = b.bar;
    __builtin_amdgcn_s_waitcnt(0);
    unsigned nloc = b.st[0], nx = b.st[1];
    if (nloc == 0u) { xcd_barrier_complete(bar, b.x, nloc, nx); b.st[0] = nloc; b.st[1] = nx; }
    const unsigned old = xb_add(&bar[XB_XSUB(b.x)], 1u);
    const unsigned gen = old / nloc;
    if (old + 1u == (gen + 1u) * nloc) {
      __builtin_amdgcn_fence(__ATOMIC_RELEASE, "agent");
      asm volatile("s_waitcnt vmcnt(0)" ::: "memory");
      const unsigned og = xb_add(&bar[XB_TOP], 1u);
      const unsigned tg = og / nx;
      if (og + 1u == (tg + 1u) * nx) xb_add(&bar[XB_TOPGEN], 1u);
      else XB_SPIN(xb_ld(&bar[XB_TOPGEN]) == tg, bar);
      __builtin_amdgcn_fence(__ATOMIC_ACQUIRE, "agent");
      xb_add(&bar[XB_XGEN(b.x)], 1u);
      asm volatile("s_waitcnt vmcnt(0)" ::: "memory");
    } else {
      XB_SPIN(xb_ld(&bar[XB_XGEN(b.x)]) == gen, bar);
      __builtin_amdgcn_fence(__ATOMIC_ACQUIRE, "agent");
      asm volatile("s_waitcnt vmcnt(0)" ::: "memory");
    }
  }
  __syncthreads();
}

DI void transpose_tiles(const float* __restrict__ W, bf16_t* __restrict__ Wt, int K, int N, float* lds) {
  const int tn = N / 64, ntile = (K / 64) * tn, tid = tid_();
  for (int tile = blockIdx.x; tile < ntile; tile += gridDim.x) {
    const int k0 = (tile / tn) * 64, n0 = (tile % tn) * 64;
    const int r = tid >> 4, c4 = tid & 15;
#pragma unroll
    for (int i = 0; i < 2; i++) {
      float4 v = *(const float4*)&W[(size_t)(k0 + r + 32 * i) * N + n0 + c4 * 4];
      float* d = &lds[(r + 32 * i) * 65 + c4 * 4]; d[0] = v.x; d[1] = v.y; d[2] = v.z; d[3] = v.w;
    }
    __syncthreads();
    const int n = tid >> 3, kc = tid & 7;
    u32x4 o;
#pragma unroll
    for (int j = 0; j < 4; j++) o[j] = pack2(lds[(kc * 8 + 2 * j) * 65 + n], lds[(kc * 8 + 2 * j + 1) * 65 + n]);
    *(u32x4*)&Wt[(size_t)(n0 + n) * K + k0 + kc * 8] = o;
    __syncthreads();
  }
}
DI void convert_bf16(const float* __restrict__ src, bf16_t* __restrict__ dst, size_t n8) {
  for (size_t i = (size_t)blockIdx.x * NTH + tid_(); i < n8; i += (size_t)gridDim.x * NTH) {
    float4 a = *(const float4*)&src[i * 8], b = *(const float4*)&src[i * 8 + 4];
    u32x4 o = {pack2(a.x, a.y), pack2(a.z, a.w), pack2(b.x, b.y), pack2(b.z, b.w)};
    *(u32x4*)&dst[i * 8] = o;
  }
}

DI void convert_fp8_rows(const float* __restrict__ src, unsigned char* __restrict__ dst, float* __restrict__ invs, int rows) {
  const int lane = tid_() & 63, wave = tid_() >> 6;
  for (int r = blockIdx.x * 8 + wave; r < rows; r += gridDim.x * 8) {
    const float* x = src + (size_t)r * 2048;
    float4 v[8]; float mx = 0.f;
#pragma unroll
    for (int hsel = 0; hsel < 2; hsel++)
#pragma unroll
      for (int i = 0; i < 4; i++) {
        v[hsel * 4 + i] = *(const float4*)&x[hsel * 1024 + lane * 16 + i * 4];
        const float4 a = v[hsel * 4 + i];
        mx = fmaxf(mx, fmaxf(fmaxf(fabsf(a.x), fabsf(a.y)), fmaxf(fabsf(a.z), fabsf(a.w))));
      }
    mx = fmaxf(wave_max(mx), 1e-30f);
    const float sc = 224.f / mx;
    if (lane == 0) invs[r] = mx * (1.f / 224.f);
#pragma unroll
    for (int hsel = 0; hsel < 2; hsel++) {
      u32x4 o;
#pragma unroll
      for (int i = 0; i < 4; i++) {
        const float4 a = v[hsel * 4 + i];
        int w = __builtin_amdgcn_cvt_pk_fp8_f32(a.x * sc, a.y * sc, 0, false);
        w = __builtin_amdgcn_cvt_pk_fp8_f32(a.z * sc, a.w * sc, w, true);
        o[i] = (unsigned)w;
      }
      *(u32x4*)&dst[(size_t)r * 2048 + hsel * 1024 + lane * 16] = o;
    }
  }
}
DI void convert_fp8_rows_w(const float* __restrict__ src, unsigned char* __restrict__ dst, float* __restrict__ invs, int rows, int widx, int nw) {
  const int lane = tid_() & 63;
  for (int r = widx; r < rows; r += nw) {
    const float* x = src + (size_t)r * 2048;
    float4 v[8]; float mx = 0.f;
#pragma unroll
    for (int hsel = 0; hsel < 2; hsel++)
#pragma unroll
      for (int i = 0; i < 4; i++) {
        v[hsel * 4 + i] = *(const float4*)&x[hsel * 1024 + lane * 16 + i * 4];
        const float4 a = v[hsel * 4 + i];
        mx = fmaxf(mx, fmaxf(fmaxf(fabsf(a.x), fabsf(a.y)), fmaxf(fabsf(a.z), fabsf(a.w))));
      }
    mx = fmaxf(wave_max(mx), 1e-30f);
    const float sc = 224.f / mx;
    if (lane == 0) invs[r] = mx * (1.f / 224.f);
#pragma unroll
    for (int hsel = 0; hsel < 2; hsel++) {
      u32x4 o;
#pragma unroll
      for (int i = 0; i < 4; i++) {
        const float4 a = v[hsel * 4 + i];
        int w = __builtin_amdgcn_cvt_pk_fp8_f32(a.x * sc, a.y * sc, 0, false);
        w = __builtin_amdgcn_cvt_pk_fp8_f32(a.z * sc, a.w * sc, w, true);
        o[i] = (unsigned)w;
      }
      *(u32x4*)&dst[(size_t)r * 2048 + hsel * 1024 + lane * 16] = o;
    }
  }
}
DI void transpose_tiles_w(const float* __restrict__ W, bf16_t* __restrict__ Wt, int K, int N, float* wl, int widx, int nw) {
  const int lane = tid_() & 63;
  const int tn = N / 64, ntile = (K / 64) * tn;
  for (int tile = widx; tile < ntile; tile += nw) {
    const int k0 = (tile / tn) * 64, n0 = (tile % tn) * 64;
    const int r = lane >> 4, c4 = lane & 15;
#pragma unroll
    for (int i = 0; i < 16; i++) {
      const float4 v = *(const float4*)&W[(size_t)(k0 + r + 4 * i) * N + n0 + c4 * 4];
      float* d = &wl[(r + 4 * i) * 65 + c4 * 4]; d[0] = v.x; d[1] = v.y; d[2] = v.z; d[3] = v.w;
    }
    asm volatile("s_waitcnt lgkmcnt(0)" ::: "memory");
#pragma unroll
    for (int kc = 0; kc < 8; kc++) {
      u32x4 o;
#pragma unroll
      for (int j = 0; j < 4; j++) o[j] = pack2(wl[(kc * 8 + 2 * j) * 65 + lane], wl[(kc * 8 + 2 * j + 1) * 65 + lane]);
      *(u32x4*)&Wt[(size_t)(n0 + lane) * K + k0 + kc * 8] = o;
    }
    asm volatile("s_waitcnt lgkmcnt(0)" ::: "memory");
  }
}
DI void unpack16_fp8(u32x4 u, float* f) {
#pragma unroll
  for (int i = 0; i < 4; i++) {
    const auto lo = __builtin_amdgcn_cvt_pk_f32_fp8((int)u[i], false), hi = __builtin_amdgcn_cvt_pk_f32_fp8((int)u[i], true);
    f[i * 4] = lo[0]; f[i * 4 + 1] = lo[1]; f[i * 4 + 2] = hi[0]; f[i * 4 + 3] = hi[1];
  }
}

DI void phase_mod_partial(const Params& p) {
  const float* mod_w = p.in[IN_MOD_W]; const float* c = p.in[IN_C]; const float* cctx = p.in[IN_C_CTX];
  float* mpart = (float*)(p.ws + WS_MPART);
  for (int it = blockIdx.x; it < 768; it += gridDim.x) {
    const int l = it / 384, rem = it % 384, kc = rem / 6, jb = rem % 6;
    const int j = jb * 2048 + tid_() * 4;
    float4 a0 = {0, 0, 0, 0}, a1 = a0, a2 = a0;
    for (int kk = 0; kk < 32; kk++) {
      const int k = kc * 32 + kk;
      const float4 w = *(const float4*)&mod_w[((size_t)l * 2048 + k) * 12288 + j];
      float x0 = cctx[k], x1 = c[k], x2 = c[2048 + k];
      float s0 = x0 * sigmoidf_(x0), s1 = x1 * sigmoidf_(x1), s2 = x2 * sigmoidf_(x2);
      a0.x += s0 * w.x; a0.y += s0 * w.y; a0.z += s0 * w.z; a0.w += s0 * w.w;
      a1.x += s1 * w.x; a1.y += s1 * w.y; a1.z += s1 * w.z; a1.w += s1 * w.w;
      a2.x += s2 * w.x; a2.y += s2 * w.y; a2.z += s2 * w.z; a2.w += s2 * w.w;
    }
    float* o = mpart + ((size_t)(l * 64 + kc) * 3) * 12288 + j;
    *(float4*)o = a0; *(float4*)(o + 12288) = a1; *(float4*)(o + 2 * 12288) = a2;
  }
}
DI void phase_mod_reduce(const Params& p) {
  const float* mpart = (const float*)(p.ws + WS_MPART); float* m = (float*)(p.ws + WS_MOD); const float* mod_b = p.in[IN_MOD_B];
  for (int i = blockIdx.x * NTH + tid_(); i < 2 * 3 * 12288; i += gridDim.x * NTH) {
    const int l = i / 36864, rem = i % 36864, cv = rem / 12288, j = rem % 12288;
    float s = mod_b[l * 12288 + j];
    for (int kc = 0; kc < 64; kc++) s += mpart[((size_t)(l * 64 + kc) * 3 + cv) * 12288 + j];
    m[i] = s;
  }
}

DI void phase_hdn2(const Params& p) {
  const float* fw1 = p.in[IN_OC_FW1]; const float* fb1 = p.in[IN_OC_FB1]; const float* fr = p.in[IN_OC_FREQ];
  const float* fw2 = p.in[IN_OC_FW2]; const float* fb2 = p.in[IN_OC_FB2];
  float* hdn2 = (float*)(p.ws + WS_HDN2);
  const int lane = tid_() & 63, wave = tid_() >> 6;
  for (int row = blockIdx.x * 8 + wave; row < 4352; row += gridDim.x * 8) {
    const int L = row < 256 ? 256 : 4096, i = row < 256 ? row : row - 256;
    const float tl = (float)i / (float)(L - 1);
    const float wpos = 6.283185307179586f * (float)i / (float)L;
    float acc = fb1[lane] + tl * fw1[lane];
    for (int b = 0; b < 16; b++) {
      const float f = 1e-4f + (float)b * ((15.f - 1e-4f) / 15.f);
      const float ang = f * wpos;
      acc += cosf(ang) * fw1[(1 + b) * 64 + lane];
      acc += -sinf(ang) * fw1[(17 + b) * 64 + lane];
    }
    const float h1 = sinf(fr[lane] * acc);
    float acc2 = fb2[lane];
    for (int k = 0; k < 64; k++) acc2 += __shfl(h1, k) * fw2[k * 64 + lane];
    const float h2 = sinf(fr[lane] * acc2);
    hdn2[row * 64 + lane] = h2; ((bf16_t*)(p.ws + WS_HDN2B))[row * 64 + lane] = f2bf(h2);
  }
}

DI void phase_norm(const float* __restrict__ x0, const float* __restrict__ x1, const float* __restrict__ gamma,
                   const float* __restrict__ mod, int sh_off, int sc_off, bf16_t* __restrict__ hm) {
  const int lane = tid_() & 63, wave = tid_() >> 6;
  for (int t = blockIdx.x * 8 + wave; t < T; t += gridDim.x * 8) {
    const float* x = t < TP ? x0 + (size_t)t * 2048 : x1 + (size_t)(t - TP) * 2048;
    const float* m = mod + cvec_of(t) * 12288;
    float4 v[8]; float ss = 0;
#pragma unroll
    for (int i = 0; i < 8; i++) { v[i] = ((const float4*)x)[i * 64 + lane]; ss += v[i].x * v[i].x + v[i].y * v[i].y + v[i].z * v[i].z + v[i].w * v[i].w; }
    ss = wave_sum(ss);
    const float rstd = rsqrtf(ss * (1.f / 2048.f) + 1e-6f);
#pragma unroll
    for (int i = 0; i < 8; i++) {
      const int n = (i * 64 + lane) * 4;
      const float4 g = *(const float4*)&gamma[n], sc = *(const float4*)&m[sc_off + n], sh = *(const float4*)&m[sh_off + n];
      float a = v[i].x * rstd * g.x * (1.f + sc.x) + sh.x, b = v[i].y * rstd * g.y * (1.f + sc.y) + sh.y;
      float c = v[i].z * rstd * g.z * (1.f + sc.z) + sh.z, d = v[i].w * rstd * g.w * (1.f + sc.w) + sh.w;
      u32x2 o = {pack2(a, b), pack2(c, d)};
      *(u32x2*)&hm[(size_t)t * 2048 + n] = o;
    }
  }
}

template <int BN, class Epi>
DI void gemm_tile(const bf16_t* __restrict__ A, int lda, const bf16_t* __restrict__ Bt, int ldb, int m0, int n0, int N, int K, const Epi& epi, char* lds) {
  constexpr int WN = BN / 4, NJ = WN / 32, NB = BN / 64;
  constexpr int ROWB = 144;
  constexpr int STAGE = (256 + BN) * ROWB;
  const int tid = tid_(), wave = tid >> 6, lane = tid & 63, r32 = lane & 31, h = lane >> 5;
  const int wm = wave >> 2, wn = wave & 3;
  f32x16 acc[4][NJ];
#pragma unroll
  for (int i = 0; i < 4; i++)
#pragma unroll
    for (int j = 0; j < NJ; j++)
#pragma unroll
      for (int r = 0; r < 16; r++) acc[i][j][r] = 0.f;
  u32x4 ra[4], rb[NB];
  const int srow = tid >> 3, sc = tid & 7;
  const bf16_t* Ap = A + (size_t)(m0 + srow) * lda + sc * 8;
  const bf16_t* Bp[NB];
#pragma unroll
  for (int i = 0; i < NB; i++) { int n = n0 + srow + 64 * i; n = n < N ? n : N - 1; Bp[i] = Bt + (size_t)n * ldb + sc * 8; }
  auto gload = [&](int k0) {
#pragma unroll
    for (int i = 0; i < 4; i++) ra[i] = *(const u32x4*)(Ap + (size_t)(64 * i) * lda + k0);
#pragma unroll
    for (int i = 0; i < NB; i++) rb[i] = *(const u32x4*)(Bp[i] + k0);
  };
  auto swrite = [&](int st) {
    char* As = lds + st * STAGE; char* Bs = As + 256 * ROWB;
#pragma unroll
    for (int i = 0; i < 4; i++) *(u32x4*)(As + (srow + 64 * i) * ROWB + sc * 16) = ra[i];
#pragma unroll
    for (int i = 0; i < NB; i++) *(u32x4*)(Bs + (srow + 64 * i) * ROWB + sc * 16) = rb[i];
  };
  auto compute = [&](int st, int ks) {
    const char* As = lds + st * STAGE; const char* Bs = As + 256 * ROWB;
    bf16x8 af[4], bfr[NJ];
#pragma unroll
    for (int i = 0; i < 4; i++) af[i] = *(const bf16x8*)(As + (wm * 128 + i * 32 + r32) * ROWB + (ks * 16 + h * 8) * 2);
#pragma unroll
    for (int j = 0; j < NJ; j++) bfr[j] = *(const bf16x8*)(Bs + (wn * WN + j * 32 + r32) * ROWB + (ks * 16 + h * 8) * 2);
#pragma unroll
    for (int i = 0; i < 4; i++)
#pragma unroll
      for (int j = 0; j < NJ; j++) acc[i][j] = __builtin_amdgcn_mfma_f32_32x32x16_bf16(af[i], bfr[j], acc[i][j], 0, 0, 0);
  };
  const int KT = K / 64;
  __syncthreads();
  gload(0); swrite(0);
  if (KT > 1) gload(64);
  __syncthreads();
  for (int kt = 0; kt < KT; kt++) {
    const int st = kt & 1;
    compute(st, 0); compute(st, 1);
    if (kt + 1 < KT) { swrite(st ^ 1); if (kt + 2 < KT) gload((kt + 2) * 64); }
    compute(st, 2); compute(st, 3);
    __syncthreads();
  }
#pragma unroll
  for (int i = 0; i < 4; i++)
#pragma unroll
    for (int j = 0; j < NJ; j++) {
      const int n = n0 + wn * WN + j * 32 + r32;
      __builtin_amdgcn_sched_barrier(0);
      if (n < N) {
#pragma unroll
        for (int r = 0; r < 16; r++) {
          epi(m0 + wm * 128 + i * 32 + crow(r, h), n, acc[i][j][r]);
          if ((r + 1) % Epi::GROUP == 0) asm volatile("" ::: "memory");
        }
      }
    }
}
struct EpiBF16 { static constexpr int GROUP = 16; bf16_t* C; size_t ldc; DI void operator()(int m, int n, float v) const { C[(size_t)m * ldc + n] = f2bf(v); } };
struct EpiF32  { static constexpr int GROUP = 16; float* C; size_t ldc; DI void operator()(int m, int n, float v) const { C[(size_t)m * ldc + n] = v; } };
struct EpiW { static constexpr int GROUP = 16; float* W; const float* w0; int d;
  DI void operator()(int m, int n, float v) const { W[((size_t)m * 2 + d) * 1024 + n] = __expf(-0.6065306597f * sigmoidf_(w0[d * 1024 + n] + v)); } };
struct EpiA { static constexpr int GROUP = 16; bf16_t* Ab; const float* a0; int d;
  DI void operator()(int m, int n, float v) const { Ab[((size_t)m * 2 + d) * 1024 + n] = f2bf(sigmoidf_(a0[d * 1024 + n] + v)); } };
struct EpiRes { static constexpr int GROUP = 16; const float* xp; const float* xs; const float* gt; float* out;
  DI void operator()(int m, int n, float v) const {
    const float xin = m < TP ? xp[(size_t)m * 2048 + n] : xs[(size_t)(m - TP) * 2048 + n];
    out[(size_t)m * 2048 + n] = xin + gt[cvec_of(m) * 12288 + n] * v; } };

template <int BN, class Epi>
DI void gemm_full(const bf16_t* A, int lda, const bf16_t* Bt, int ldb, int M, int N, int K, const Epi& epi, char* lds) {
  const int tn = (N + BN - 1) / BN, ntile = (M / 256) * tn;
  for (int tile = blockIdx.x; tile < ntile; tile += gridDim.x) gemm_tile<BN>(A, lda, Bt, ldb, (tile / tn) * 256, (tile % tn) * BN, N, K, epi, lds);
}

constexpr int AD = 128, ANW = 8, AQBLK = 32, AKVBLK = 64;
constexpr float ASCALE = 0.088388347648318440f;
constexpr float ATHR = 8.f;
constexpr size_t SHM_V = AKVBLK * AD * 2, SHM_K = AKVBLK * AD * 2, SHM_ATTN = 2 * SHM_V + 2 * SHM_K + ANW * 64 * 4;
#define KSWZ(row, colB) ((row) * 256 + ((colB) ^ (((row) & 7) << 4)))
#define SBAR() __builtin_amdgcn_sched_barrier(0)
DI unsigned cvtpk(float lo, float hi) { unsigned r; asm volatile("v_cvt_pk_bf16_f32 %0, %1, %2" : "=v"(r) : "v"(lo), "v"(hi)); return r; }
DI void partialSM(f32x16& p0, f32x16& p1, float& m_reg, float& mn, float& alpha) {
  constexpr float C = ASCALE * 1.4426950408889634f;
  float pmax = p0[0];
#pragma unroll
  for (int r = 1; r < 16; ++r) pmax = fmaxf(pmax, p0[r]);
#pragma unroll
  for (int r = 0; r < 16; ++r) pmax = fmaxf(pmax, p1[r]);
  { auto rr = __builtin_amdgcn_permlane32_swap(__float_as_uint(pmax), __float_as_uint(pmax), false, false);
    pmax = fmaxf(__uint_as_float(rr[0]), __uint_as_float(rr[1])); }
  if (__builtin_expect(__all(pmax - m_reg <= ATHR / ASCALE), 1)) { mn = m_reg; alpha = 1.f; }
  else { mn = fmaxf(m_reg, pmax); alpha = __builtin_amdgcn_exp2f((m_reg - mn) * C); m_reg = mn; }
  float mnC = -mn * C;
#pragma unroll
  for (int r = 0; r < 16; ++r) p0[r] = fmaf(p0[r], C, mnC);
#pragma unroll
  for (int r = 0; r < 16; ++r) p1[r] = fmaf(p1[r], C, mnC);
#pragma unroll
  for (int r = 0; r < 16; ++r) p0[r] = __builtin_amdgcn_exp2f(p0[r]);
}
DI void finishSM(f32x16& p0, f32x16& p1, float alpha, float& l_reg, bf16x8& pa0, bf16x8& pa1, bf16x8& pa2, bf16x8& pa3) {
#pragma unroll
  for (int r = 0; r < 16; ++r) p1[r] = __builtin_amdgcn_exp2f(p1[r]);
  float ps = 0;
#pragma unroll
  for (int r = 0; r < 16; ++r) ps += p0[r];
#pragma unroll
  for (int r = 0; r < 16; ++r) ps += p1[r];
  { auto rr = __builtin_amdgcn_permlane32_swap(__float_as_uint(ps), __float_as_uint(ps), false, false);
    ps = __uint_as_float(rr[0]) + __uint_as_float(rr[1]); }
  l_reg = l_reg * alpha + ps;
#define PK4(P, BASE, OUT) do { unsigned a0 = cvtpk(P[BASE + 0], P[BASE + 1]), a1 = cvtpk(P[BASE + 2], P[BASE + 3]);   \
    unsigned b0 = cvtpk(P[BASE + 4], P[BASE + 5]), b1 = cvtpk(P[BASE + 6], P[BASE + 7]);                              \
    auto r0 = __builtin_amdgcn_permlane32_swap(a0, b0, false, false); auto r1 = __builtin_amdgcn_permlane32_swap(a1, b1, false, false); \
    u32x4 w = {r0[0], r1[0], r0[1], r1[1]}; OUT = *reinterpret_cast<bf16x8*>(&w); } while (0)
  PK4(p0, 0, pa0); PK4(p0, 8, pa1); PK4(p1, 0, pa2); PK4(p1, 8, pa3);
#undef PK4
}
DI void qkt(f32x16& p0, f32x16& p1, const bf16_t* Ks, const bf16x8* qr, int r32, int hi) {
#pragma unroll
  for (int r = 0; r < 16; ++r) { p0[r] = 0.f; p1[r] = 0.f; }
#pragma unroll
  for (int d0 = 0; d0 < 8; ++d0) { int cb = (d0 * 16 + hi * 8) * 2;
    bf16x8 b0 = *reinterpret_cast<const bf16x8*>((const char*)Ks + KSWZ(r32, cb));
    bf16x8 b1 = *reinterpret_cast<const bf16x8*>((const char*)Ks + KSWZ(32 + r32, cb));
    p0 = __builtin_amdgcn_mfma_f32_32x32x16_bf16(b0, qr[d0], p0, 0, 0, 0);
    p1 = __builtin_amdgcn_mfma_f32_32x32x16_bf16(b1, qr[d0], p1, 0, 0, 0); }
}
DI int v_st(int k, int c) { const int kk = (k & ~0xC) | ((k & 4) << 1) | ((k & 8) >> 1); return ((kk >> 3) * 4 + (c >> 5)) * 512 + ((kk & 7) * 32 + (c & 31)) * 2; }
DI int v_rd_base(int lane) { return ((lane & 3) << 3) | (((lane >> 2) & 3) << 6) | (((lane >> 4) & 1) << 5) | (((lane >> 5) & 1) << 8); }
constexpr int v_rd_off(int d0, int ks, int half) { return d0 * 512 + ks * 4096 + half * 2048; }
template <int OFF> DI s16x4 tr_read(int vb) {
  s16x4 r; asm volatile("ds_read_b64_tr_b16 %0, %1 offset:%2" : "=&v"(r) : "v"(vb), "i"(OFF) : "memory"); return r;
}
template <int D0> DI void pv_one(f32x16& od, int vb, bf16x8 pa0, bf16x8 pa1, bf16x8 pa2, bf16x8 pa3) {
  const s16x4 l0 = tr_read<v_rd_off(D0, 0, 0)>(vb), h0 = tr_read<v_rd_off(D0, 0, 1)>(vb), l1 = tr_read<v_rd_off(D0, 1, 0)>(vb), h1 = tr_read<v_rd_off(D0, 1, 1)>(vb);
  const s16x4 l2 = tr_read<v_rd_off(D0, 2, 0)>(vb), h2 = tr_read<v_rd_off(D0, 2, 1)>(vb), l3 = tr_read<v_rd_off(D0, 3, 0)>(vb), h3 = tr_read<v_rd_off(D0, 3, 1)>(vb);
  asm volatile("s_waitcnt lgkmcnt(0)" ::: "memory"); SBAR();
#define PK(L, H) (bf16x8){L[0], L[1], L[2], L[3], H[0], H[1], H[2], H[3]}
  od = __builtin_amdgcn_mfma_f32_32x32x16_bf16(pa0, PK(l0, h0), od, 0, 0, 0);
  od = __builtin_amdgcn_mfma_f32_32x32x16_bf16(pa1, PK(l1, h1), od, 0, 0, 0);
  od = __builtin_amdgcn_mfma_f32_32x32x16_bf16(pa2, PK(l2, h2), od, 0, 0, 0);
  od = __builtin_amdgcn_mfma_f32_32x32x16_bf16(pa3, PK(l3, h3), od, 0, 0, 0);
#undef PK
}
DI void pv_d0(f32x16* o, int vb, bf16x8 pa0, bf16x8 pa1, bf16x8 pa2, bf16x8 pa3) {
  pv_one<0>(o[0], vb, pa0, pa1, pa2, pa3); pv_one<1>(o[1], vb, pa0, pa1, pa2, pa3); pv_one<2>(o[2], vb, pa0, pa1, pa2, pa3); pv_one<3>(o[3], vb, pa0, pa1, pa2, pa3);
}
template <int LDQ, int LDK, int LDO>
DI void attn_dense_body(const bf16_t* __restrict__ Qb, const bf16_t* __restrict__ Kh, const bf16_t* __restrict__ Vh,
                        bf16_t* __restrict__ Ob, int seq, char* lds) {
  const int tid = tid_(), wid = tid >> 6, lane = tid & 63, r32 = lane & 31, hi = lane >> 5;
  bf16_t* V_lds = (bf16_t*)lds; bf16_t* K_lds = (bf16_t*)(lds + 2 * SHM_V);
  float* wsf = (float*)(lds + 2 * SHM_V + 2 * SHM_K) + wid * 64; float* li_l = wsf; float* al_l = wsf + 32;
  float m_reg = -1e30f, l_reg = 0; f32x16 o[4]; bf16x8 qr[8];
#pragma unroll
  for (int d = 0; d < 4; d++)
#pragma unroll
    for (int r = 0; r < 16; r++) o[d][r] = 0.f;
  const bf16_t* Qw = Qb + (long)(wid * AQBLK + r32) * LDQ + hi * 8;
#pragma unroll
  for (int d0 = 0; d0 < 8; ++d0) qr[d0] = *reinterpret_cast<const bf16x8*>(Qw + d0 * 16);
  const int sr = tid >> 4, sc = (tid & 15) * 8, vst0 = v_st(sr, sc), vst1 = v_st(32 + sr, sc);
  const int vb0 = (int)(uintptr_t)V_lds + v_rd_base(lane);
  struct { bf16x8 vs0, vs1, ks0, ks1; } sr_[2];
#define SLOAD(i, k0) do { sr_[i].vs0 = *(const bf16x8*)(&Vh[(long)((k0) + sr) * LDK + sc]); sr_[i].vs1 = *(const bf16x8*)(&Vh[(long)((k0) + 32 + sr) * LDK + sc]); \
    sr_[i].ks0 = *(const bf16x8*)(&Kh[(long)((k0) + sr) * LDK + sc]); sr_[i].ks1 = *(const bf16x8*)(&Kh[(long)((k0) + 32 + sr) * LDK + sc]); } while (0)
#define SWRITE(b, i) do { *(bf16x8*)((char*)V_lds + (b) * SHM_V + vst0) = sr_[i].vs0;          \
    *(bf16x8*)((char*)V_lds + (b) * SHM_V + vst1) = sr_[i].vs1; int kc = sc * 2;               \
    *(bf16x8*)((char*)K_lds + (b) * SHM_K + KSWZ(sr, kc)) = sr_[i].ks0;                       \
    *(bf16x8*)((char*)K_lds + (b) * SHM_K + KSWZ(32 + sr, kc)) = sr_[i].ks1; } while (0)
#define SWAIT() do { asm volatile("s_waitcnt vmcnt(4)" ::: "memory"); } while (0)
#define RESC(a) do { if (__any((a) < 1.f)) { if (hi == 0) al_l[r32] = (a); asm volatile("s_waitcnt lgkmcnt(0)" ::: "memory"); \
    _Pragma("unroll") for (int d = 0; d < 4; ++d) _Pragma("unroll") for (int r = 0; r < 16; ++r) o[d][r] *= al_l[crow(r, hi)]; } } while (0)
  f32x16 pA0, pA1, pB0, pB1; float mnA, mnB, alA, alB; bf16x8 pa0, pa1, pa2, pa3; const int NTL = seq / AKVBLK;
  constexpr int SE = 0, SO = 1;
  SLOAD(SE, 0); asm volatile("s_waitcnt vmcnt(0)" ::: "memory"); SWRITE(0, SE); __syncthreads();
  qkt(pA0, pA1, K_lds, qr, r32, hi); partialSM(pA0, pA1, m_reg, mnA, alA);
  SLOAD(SO, AKVBLK); if (2 < NTL) SLOAD(SE, 2 * AKVBLK);
  SWAIT(); SWRITE(1, SO); __syncthreads();
  for (int j = 1; j + 1 < NTL; j += 2) {
    SBAR(); qkt(pB0, pB1, (bf16_t*)((char*)K_lds + SHM_K), qr, r32, hi);
    finishSM(pA0, pA1, alA, l_reg, pa0, pa1, pa2, pa3); SBAR();
    SLOAD(SO, (j + 2) * AKVBLK); SBAR();
    pv_d0(o, vb0, pa0, pa1, pa2, pa3); partialSM(pB0, pB1, m_reg, mnB, alB);
    __syncthreads(); SWAIT(); SWRITE(0, SE);
    RESC(alB); __syncthreads();
    SBAR(); qkt(pA0, pA1, K_lds, qr, r32, hi);
    finishSM(pB0, pB1, alB, l_reg, pa0, pa1, pa2, pa3); SBAR();
    if (j + 3 < NTL) SLOAD(SE, (j + 3) * AKVBLK); SBAR();
    pv_d0(o, vb0 + (int)SHM_V, pa0, pa1, pa2, pa3); partialSM(pA0, pA1, m_reg, mnA, alA);
    __syncthreads(); SWAIT(); SWRITE(1, SO);
    RESC(alA); __syncthreads();
  }
  SBAR(); qkt(pB0, pB1, (bf16_t*)((char*)K_lds + SHM_K), qr, r32, hi);
  finishSM(pA0, pA1, alA, l_reg, pa0, pa1, pa2, pa3); SBAR();
  pv_d0(o, vb0, pa0, pa1, pa2, pa3); partialSM(pB0, pB1, m_reg, mnB, alB);
  __syncthreads(); RESC(alB);
  finishSM(pB0, pB1, alB, l_reg, pa0, pa1, pa2, pa3); SBAR();
  pv_d0(o, vb0 + (int)SHM_V, pa0, pa1, pa2, pa3);
  if (hi == 0) li_l[r32] = l_reg; asm volatile("s_waitcnt lgkmcnt(0)" ::: "memory");
  float rli[16];
#pragma unroll
  for (int r = 0; r < 16; ++r) rli[r] = __builtin_amdgcn_rcpf(li_l[crow(r, hi)]);
  bf16_t* Ow = Ob + (long)(wid * AQBLK) * LDO;
#pragma unroll
  for (int r = 0; r < 16; ++r) { int orow = crow(r, hi);
#pragma unroll
    for (int d0 = 0; d0 < 4; ++d0) { const float ov = o[d0][r] * rli[r]; Ow[(long)orow * LDO + d0 * 32 + r32] = (bf16_t)(cvtpk(ov, ov) & 0xffffu); } }
#undef SLOAD
#undef SWRITE
#undef SWAIT
#undef RESC
}

DI void phase_prep0(const Params& p, char* lds) {
  const bf16_t* z0 = (const bf16_t*)(p.ws + WS_Z0);
  bf16_t* Qb = (bf16_t*)(p.ws + WS_QB);
  bf16_t* Kbp = (bf16_t*)(p.ws + WS_KBP); bf16_t* Vbp = (bf16_t*)(p.ws + WS_VBP);
  bf16_t* Kbs = (bf16_t*)(p.ws + WS_KBS); bf16_t* Vbs = (bf16_t*)(p.ws + WS_VBS);
  const float* qn = p.in[IN_EB_QN]; const float* kn = p.in[IN_EB_KN];
  float* outk = p.out + OUT_NK; float* outv = p.out + OUT_NV;
  const int tid = tid_(), lane = tid & 63, wave = tid >> 6;
  float* R = (float*)(p.ws + WS_R); float* KK = (float*)(p.ws + WS_KK); float* V = (float*)(p.ws + WS_V);
  float* KT = (float*)(p.ws + WS_KT);
  float* BON = (float*)(p.ws + WS_BON); bf16_t* actA = (bf16_t*)(p.ws + WS_ACTA);
  const float* k_k = p.in[IN_EA_KK]; const float* r_k = p.in[IN_EA_RK];
  float* cwl = (float*)lds;
  __syncthreads();
  for (int i = tid; i < 3 * 3456; i += NTH) cwl[i] = p.in[IN_EA_CONV][i];
  __syncthreads();
  for (int t = blockIdx.x * 8 + wave; t < T; t += gridDim.x * 8) {
    const bf16_t* zr = z0 + (size_t)t * ZC;
    const bool latent = t >= TP;
    const int tl = latent ? ((t - TP) & 4095) : (t & 255);
    const int L = latent ? 4096 : 256;
    const bool hasp = tl > 0, hasn = tl < L - 1;
    const float hp = hasp ? 1.f : 0.f, hn = hasn ? 1.f : 0.f;
    const bf16_t* zpr = hasp ? zr - ZC : zr; const bf16_t* znr = hasn ? zr + ZC : zr;
    float ze[20];
#pragma unroll
    for (int hh = 0; hh < 10; hh++) { ze[2 * hh] = bf2f(zr[3456 + hh * 128 + lane]); ze[2 * hh + 1] = bf2f(zr[3456 + hh * 128 + 64 + lane]); }
    const u32x2 vraw = *(const u32x2*)&zr[3456 + 1280 + lane * 4];
    u32x4 zz[3][2][3];
#pragma unroll
    for (int sec = 0; sec < 3; sec++)
#pragma unroll
      for (int hv = 0; hv < 2; hv++) {
        const int col = sec * 1024 + lane * 16 + hv * 8;
        zz[sec][hv][0] = *(const u32x4*)&zpr[col]; zz[sec][hv][1] = *(const u32x4*)&zr[col]; zz[sec][hv][2] = *(const u32x4*)&znr[col];
      }
    u32x4 zl[3];
    { const int col = 3072 + (lane < 48 ? lane : 0) * 8;
      zl[0] = *(const u32x4*)&zpr[col]; zl[1] = *(const u32x4*)&zr[col]; zl[2] = *(const u32x4*)&znr[col]; }
    {
      float cs0 = 1.f, sn0 = 0.f, cs1 = 1.f, sn1 = 0.f;
      if (latent) {
        const int i = lane & 31;
        const float inv = exp2f(-(float)i * 0.41524101186092029f);
        const float a0 = (float)(tl >> 6) * inv, a1 = (float)(tl & 63) * inv;
        cs0 = __cosf(a0); sn0 = __sinf(a0); cs1 = __cosf(a1); sn1 = __sinf(a1);
      }
      const float g0q = qn[lane], g1q = qn[64 + lane], g0k = kn[lane], g1k = kn[64 + lane];
#pragma unroll
      for (int hh = 0; hh < 10; hh++) {
        float e0 = ze[2 * hh], e1 = ze[2 * hh + 1];
        const float ss = wave_sum(e0 * e0 + e1 * e1);
        const float rstd = rsqrtf(ss * (1.f / 128.f) + 1e-6f);
        const bool isq = hh < 8;
        e0 *= rstd * (isq ? g0q : g0k); e1 *= rstd * (isq ? g1q : g1k);
        if (!isq && !latent) {
          const size_t o = (size_t)t * 256 + (hh - 8) * 128;
          outk[o + lane] = e0; outk[o + 64 + lane] = e1;
        }
        if (latent) {
          const float p0 = __shfl_xor(e0, 32), p1 = __shfl_xor(e1, 32);
          if (lane < 32) { e0 = e0 * cs0 - p0 * sn0; e1 = e1 * cs1 - p1 * sn1; }
          else           { e0 = p0 * sn0 + e0 * cs0; e1 = p1 * sn1 + e1 * cs1; }
        }
        if (isq) {
          bf16_t* q = Qb + (size_t)t * 1024 + hh * 128; q[lane] = f2bf(e0); q[64 + lane] = f2bf(e1);
        } else {
          bf16_t* k;
          if (!latent) k = Kbp + (size_t)t * 256 + (hh - 8) * 128;
          else { const int b = (t - TP) >> 12; k = Kbs + ((size_t)b * SKV_S + tl) * 256 + (hh - 8) * 128; }
          k[lane] = f2bf(e0); k[64 + lane] = f2bf(e1);
        }
      }
      {
        bf16_t* vd;
        if (!latent) {
          vd = Vbp + (size_t)t * 256 + lane * 4;
          float4 f = {lo2f(vraw[0]), hi2f(vraw[0]), lo2f(vraw[1]), hi2f(vraw[1])};
          *(float4*)&outv[(size_t)t * 256 + lane * 4] = f;
        } else { const int b = (t - TP) >> 12; vd = Vbs + ((size_t)b * SKV_S + tl) * 256 + lane * 4; }
        *(u32x2*)vd = vraw;
      }
    }
    {
      const int c0 = lane * 16;
      auto conv_sec = [&](int sec, float* dst) {
#pragma unroll
        for (int hv = 0; hv < 2; hv++) {
          const int col = sec * 1024 + lane * 16 + hv * 8;
          float zc[8], zp[8], zn[8];
          unpack8(zz[sec][hv][0], zp); unpack8(zz[sec][hv][1], zc); unpack8(zz[sec][hv][2], zn);
#pragma unroll
          for (int e4 = 0; e4 < 2; e4++) {
            const float4 w0 = *(const float4*)&cwl[col + e4 * 4], w1 = *(const float4*)&cwl[3456 + col + e4 * 4], w2 = *(const float4*)&cwl[6912 + col + e4 * 4];
            dst[hv * 8 + e4 * 4 + 0] = hp * zp[e4 * 4 + 0] * w0.x + zc[e4 * 4 + 0] * w1.x + hn * zn[e4 * 4 + 0] * w2.x;
            dst[hv * 8 + e4 * 4 + 1] = hp * zp[e4 * 4 + 1] * w0.y + zc[e4 * 4 + 1] * w1.y + hn * zn[e4 * 4 + 1] * w2.y;
            dst[hv * 8 + e4 * 4 + 2] = hp * zp[e4 * 4 + 2] * w0.z + zc[e4 * 4 + 2] * w1.z + hn * zn[e4 * 4 + 2] * w2.z;
            dst[hv * 8 + e4 * 4 + 3] = hp * zp[e4 * 4 + 3] * w0.w + zc[e4 * 4 + 3] * w1.w + hn * zn[e4 * 4 + 3] * w2.w;
          }
        }
      };
      float kk[16], tmp[16];
      conv_sec(1, kk);
      float ss = 0.f;
#pragma unroll
      for (int e = 0; e < 16; e++) { tmp[e] = kk[e] * k_k[c0 + e]; ss += tmp[e] * tmp[e]; }
      ss += __shfl_xor(ss, 1); ss += __shfl_xor(ss, 2);
      const float rn = rsqrtf(ss + 1e-12f);
#pragma unroll
      for (int e = 0; e < 16; e++) tmp[e] *= rn;
#pragma unroll
      for (int e4 = 0; e4 < 4; e4++) {
        const size_t o1 = (size_t)t * 1024 + c0 + e4 * 4, o2 = (size_t)t * 2048 + c0 + e4 * 4;
        const float4 k4 = {kk[e4 * 4], kk[e4 * 4 + 1], kk[e4 * 4 + 2], kk[e4 * 4 + 3]};
        const float4 n4 = {tmp[e4 * 4], tmp[e4 * 4 + 1], tmp[e4 * 4 + 2], tmp[e4 * 4 + 3]};
        *(float4*)&KK[o1] = n4;
        *(float4*)&KT[o2] = k4;
      }
      conv_sec(0, tmp);
      float bs = 0.f;
#pragma unroll
      for (int e = 0; e < 16; e++) bs += tmp[e] * kk[e] * r_k[c0 + e];
      bs += __shfl_xor(bs, 1); bs += __shfl_xor(bs, 2);
      if ((lane & 3) == 0) BON[(size_t)t * 16 + (lane >> 2)] = bs;
#pragma unroll
      for (int e4 = 0; e4 < 4; e4++) {
        const float4 r4 = {tmp[e4 * 4], tmp[e4 * 4 + 1], tmp[e4 * 4 + 2], tmp[e4 * 4 + 3]};
        *(float4*)&R[(size_t)t * 1024 + c0 + e4 * 4] = r4;
      }
      conv_sec(2, tmp);
#pragma unroll
      for (int e4 = 0; e4 < 4; e4++) {
        const float4 v4 = {tmp[e4 * 4], tmp[e4 * 4 + 1], tmp[e4 * 4 + 2], tmp[e4 * 4 + 3]};
        *(float4*)&V[(size_t)t * 1024 + c0 + e4 * 4] = v4;
      }
      if (lane < 48) {
        const int col = 3072 + lane * 8;
        float zc[8], zp[8], zn[8];
        unpack8(zl[0], zp); unpack8(zl[1], zc); unpack8(zl[2], zn);
        float o[8];
#pragma unroll
        for (int e = 0; e < 8; e++) {
          float x = hp * zp[e] * cwl[col + e] + zc[e] * cwl[3456 + col + e] + hn * zn[e] * cwl[6912 + col + e];
          if (lane < 16) x = tanhf(x); else if (lane >= 32) x = sigmoidf_(x);
          o[e] = x;
        }
        u32x4 ov = {pack2(o[0], o[1]), pack2(o[2], o[3]), pack2(o[4], o[5]), pack2(o[6], o[7])};
        *(u32x4*)&actA[(size_t)t * 384 + lane * 8] = ov;
      }
    }
  }
  {
    const float* ck = p.in[IN_CACHE_K]; const float* cvv = p.in[IN_CACHE_V];
    for (int i = blockIdx.x * NTH + tid_(); i < 2 * 512 * 256; i += gridDim.x * NTH) {
      const int b = i / (512 * 256), rem = i % (512 * 256);
      const size_t o = ((size_t)b * SKV_S + 4096) * 256 + rem;
      Kbs[o] = f2bf(ck[i]); Vbs[o] = f2bf(cvv[i]);
    }
  }
}

DI void phase_fixa(const Params& p) {
  float* KKA = (float*)(p.ws + WS_KKA); float* KT = (float*)(p.ws + WS_KT); const float* KK = (const float*)(p.ws + WS_KK); const float* ka = p.in[IN_EA_KA];
  for (int i = blockIdx.x * NTH + tid_(); i < T * 256; i += gridDim.x * NTH) {
    const int t = i >> 8, n = (i & 255) * 4;
    const size_t o1 = (size_t)t * 1024 + n, o2 = (size_t)t * 2048 + n;
    const bf16_t* Ab = (const bf16_t*)(p.ws + WS_UB);
    const u32x2 ab0 = *(const u32x2*)&Ab[o2], ab1 = *(const u32x2*)&Ab[o2 + 1024];
    const float4 a0 = {lo2f(ab0[0]), hi2f(ab0[0]), lo2f(ab0[1]), hi2f(ab0[1])}, a1 = {lo2f(ab1[0]), hi2f(ab1[0]), lo2f(ab1[1]), hi2f(ab1[1])};
    const float4 kk = *(const float4*)&KK[o1], k = *(const float4*)&KT[o2], c = *(const float4*)&ka[n];
    float4 r;
    r.x = kk.x * a0.x; r.y = kk.y * a0.y; r.z = kk.z * a0.z; r.w = kk.w * a0.w; *(float4*)&KKA[o2] = r;
    r.x = kk.x * a1.x; r.y = kk.y * a1.y; r.z = kk.z * a1.z; r.w = kk.w * a1.w; *(float4*)&KKA[o2 + 1024] = r;
    r.x = k.x * (1.f + (a0.x - 1.f) * c.x); r.y = k.y * (1.f + (a0.y - 1.f) * c.y); r.z = k.z * (1.f + (a0.z - 1.f) * c.z); r.w = k.w * (1.f + (a0.w - 1.f) * c.w); *(float4*)&KT[o2] = r;
    r.x = k.x * (1.f + (a1.x - 1.f) * c.x); r.y = k.y * (1.f + (a1.y - 1.f) * c.y); r.z = k.z * (1.f + (a1.z - 1.f) * c.z); r.w = k.w * (1.f + (a1.w - 1.f) * c.w); *(float4*)&KT[o2 + 1024] = r;
  }
}

typedef float f2v __attribute__((ext_vector_type(2)));
template <int RPL> struct ScanBuf { f2v kk[2], w[2], kka[2], kt[2], r[2]; float v[RPL]; };
template <int RPL, int DEP>
DI void scan_item(const Params& p, int tok0, int L, int dir, int head, int row0, const float* s0, float* sfin) {
  const int lane = tid_() & 63;
  const int g = lane >> 4, kq = lane & 15, k0 = kq * 4, rbase = row0 + g * RPL;
  const char* Rb = p.ws + WS_R; const char* KKb = p.ws + WS_KK; const char* Vb = p.ws + WS_V;
  const char* Wb = p.ws + WS_W; const char* KKAb = p.ws + WS_KKA; const char* KTb = p.ws + WS_KT;
  char* Yb = (char*)p.out;
  const unsigned c1 = (unsigned)(head * 64 + k0) * 4u, cv = (unsigned)(head * 64 + rbase) * 4u;
  const unsigned c2 = (unsigned)(dir * 1024 + head * 64 + k0) * 4u, cy = (unsigned)(dir * 1024 + head * 64 + rbase + (kq < RPL ? kq : 0)) * 4u;
  f2v S[RPL][2];
#pragma unroll
  for (int j = 0; j < RPL; j++)
#pragma unroll
    for (int e = 0; e < 2; e++) {
      S[j][e][0] = s0 ? s0[(rbase + j) * 64 + k0 + 2 * e] : 0.f; S[j][e][1] = s0 ? s0[(rbase + j) * 64 + k0 + 2 * e + 1] : 0.f;
    }
  ScanBuf<RPL> buf[DEP];
  auto load = [&](ScanBuf<RPL>& b, int step) {
    const unsigned tok = (unsigned)(tok0 + (dir ? L - 1 - step : step));
    const unsigned o1 = tok * 4096u + c1, o2 = tok * 8192u + c2;
    const float4 a = *(const float4*)(KKb + o1); b.kk[0] = f2v{a.x, a.y}; b.kk[1] = f2v{a.z, a.w};
    const float4 c = *(const float4*)(Rb + o1); b.r[0] = f2v{c.x, c.y}; b.r[1] = f2v{c.z, c.w};
    const float4 d = *(const float4*)(Wb + o2); b.w[0] = f2v{d.x, d.y}; b.w[1] = f2v{d.z, d.w};
    const float4 f = *(const float4*)(KKAb + o2); b.kka[0] = f2v{f.x, f.y}; b.kka[1] = f2v{f.z, f.w};
    const float4 h = *(const float4*)(KTb + o2); b.kt[0] = f2v{h.x, h.y}; b.kt[1] = f2v{h.z, h.w};
    if constexpr (RPL == 2) { const float2 v = *(const float2*)(Vb + tok * 4096u + cv); b.v[0] = v.x; b.v[1] = v.y; }
    else { const float4 v = *(const float4*)(Vb + tok * 4096u + cv); b.v[0] = v.x; b.v[1] = v.y; b.v[2] = v.z; b.v[3] = v.w; }
  };
#pragma unroll
  for (int d = 0; d < DEP; d++) { load(buf[d], d); __builtin_amdgcn_sched_barrier(0); }
  for (int sb = 0; sb < L; sb += DEP) {
#pragma unroll
    for (int d = 0; d < DEP; d++) {
      const int step = sb + d;
      ScanBuf<RPL>& b = buf[d];
      float sa[RPL], y[RPL];
#pragma unroll
      for (int j = 0; j < RPL; j++) { const f2v t = S[j][0] * b.kk[0] + S[j][1] * b.kk[1]; sa[j] = t[0] + t[1]; }
#pragma unroll
      for (int j = 0; j < RPL; j++) sa[j] = row_reduce<16>(sa[j]);
#pragma unroll
      for (int j = 0; j < RPL; j++) {
        const f2v nsa = {-sa[j], -sa[j]}, vv = {b.v[j], b.v[j]};
        f2v t0 = vv * b.kt[0], t1 = vv * b.kt[1];
        t0 = nsa * b.kka[0] + t0; t1 = nsa * b.kka[1] + t1;
        S[j][0] = S[j][0] * b.w[0] + t0; S[j][1] = S[j][1] * b.w[1] + t1;
        const f2v ya = S[j][0] * b.r[0] + S[j][1] * b.r[1];
        y[j] = ya[0] + ya[1];
      }
#pragma unroll
      for (int j = 0; j < RPL; j++) y[j] = row_reduce<16>(y[j]);
      float ysel = y[0];
#pragma unroll
      for (int j = 1; j < RPL; j++) ysel = (kq == j) ? y[j] : ysel;
      const unsigned tok = (unsigned)(tok0 + (dir ? L - 1 - step : step));
      if (kq < RPL) *(float*)(Yb + tok * 8192u + cy) = ysel;
      __builtin_amdgcn_sched_barrier(0);
      load(b, step + DEP < L ? step + DEP : L - 1);
      __builtin_amdgcn_sched_barrier(0);
    }
  }
  if (sfin) {
#pragma unroll
    for (int j = 0; j < RPL; j++)
#pragma unroll
      for (int e = 0; e < 2; e++) { sfin[(rbase + j) * 64 + k0 + 2 * e] = S[j][e][0]; sfin[(rbase + j) * 64 + k0 + 2 * e + 1] = S[j][e][1]; }
  }
}
DI void phase_scan(const Params& p, char* lds) {
  const int wave = tid_() >> 6;
  if (wave < 2) {
    for (int it = blockIdx.x * 2 + wave; it < 512; it += gridDim.x * 2) {
      const int rg = it & 7, hsd = it >> 3, head = hsd & 15, dir = (hsd >> 4) & 1, b = hsd >> 5;
      const float* s0 = p.in[IN_STATE_A] + ((size_t)(b * 2 + dir) * 16 + head) * 4096;
      scan_item<2, 8>(p, TP + b * 4096, 4096, dir, head, rg * 8, s0, nullptr);
    }
  } else if ((wave & 3) >= 2) {
    const int w4 = (wave & 1) + ((wave >> 2) << 1);
    for (int it = blockIdx.x * 4 + w4; it < 4096; it += gridDim.x * 4) {
      const int rg = it & 3, hsd = it >> 2, head = hsd & 15, dir = (hsd >> 4) & 1, b = hsd >> 5;
      float* sf = p.out + OUT_NS + ((size_t)(b * 2 + dir) * 16 + head) * 4096;
      scan_item<4, 4>(p, b * 256, 256, dir, head, rg * 16, nullptr, sf);
    }
    const int widx = blockIdx.x * 4 + w4, nw = gridDim.x * 4;
    float* wl = (float*)lds + w4 * (64 * 65);
    transpose_tiles_w(p.in[IN_EW_OUT], (bf16_t*)(p.ws + WS_WT_OUT0), 2048, 2048, wl, widx, nw);
    convert_fp8_rows_w(p.in[IN_PEER_U], (unsigned char*)(p.ws + WS_UB), (float*)(p.ws + WS_TSC), 32768, widx, nw);
    convert_fp8_rows_w(p.in[IN_PEER_V], (unsigned char*)(p.ws + WS_VB), (float*)(p.ws + WS_TSC) + 32768, 32768, widx, nw);
    transpose_tiles_w(p.in[IN_PEER_WQ], (bf16_t*)(p.ws + WS_WT_Q), 2048, 2048, wl, widx, nw);
    transpose_tiles_w(p.in[IN_OW_IN], (bf16_t*)(p.ws + WS_WT_IN1), 2048, 6144, wl, widx, nw);
    transpose_tiles_w(p.in[IN_OW_OUT], (bf16_t*)(p.ws + WS_WT_OUT1), 2048, 2048, wl, widx, nw);
    transpose_tiles_w(p.in[IN_PEER_WQ] + (size_t)2048 * 2048, (bf16_t*)(p.ws + WS_WT_Q) + (size_t)2048 * 2048, 2048, 2048, wl, widx, nw);
    transpose_tiles_w(p.in[IN_OC_FW3], (bf16_t*)(p.ws + WS_FW3T), 64, 8192, wl, widx, nw);
  }
}

DI void phase_post0(const Params& p) {
  const float* ydir = p.out; const float* V = (const float*)(p.ws + WS_V); const bf16_t* G = (const bf16_t*)(p.ws + WS_G);
  const float* BON = (const float*)(p.ws + WS_BON); const float* lnw = p.in[IN_EA_LNW]; const float* lnb = p.in[IN_EA_LNB];
  bf16_t* A2 = (bf16_t*)(p.ws + WS_A2);
  const int lane = tid_() & 63, wave = tid_() >> 6;
  for (int t = blockIdx.x * 8 + wave; t < T; t += gridDim.x * 8) {
    const int c0 = lane * 16;
    float y[16]; float s = 0.f;
#pragma unroll
    for (int e4 = 0; e4 < 4; e4++) {
      const float4 a = *(const float4*)&ydir[(size_t)t * 2048 + c0 + e4 * 4], b = *(const float4*)&ydir[(size_t)t * 2048 + 1024 + c0 + e4 * 4];
      y[e4 * 4] = a.x + b.x; y[e4 * 4 + 1] = a.y + b.y; y[e4 * 4 + 2] = a.z + b.z; y[e4 * 4 + 3] = a.w + b.w;
    }
#pragma unroll
    for (int e = 0; e < 16; e++) s += y[e];
    s += __shfl_xor(s, 1); s += __shfl_xor(s, 2);
    const float mu = s * (1.f / 64.f);
    float vs = 0.f;
#pragma unroll
    for (int e = 0; e < 16; e++) { const float d = y[e] - mu; vs += d * d; }
    vs += __shfl_xor(vs, 1); vs += __shfl_xor(vs, 2);
    const float rstd = rsqrtf(vs * (1.f / 64.f) + 64e-5f);
    const float bon = BON[(size_t)t * 16 + (lane >> 2)];
    float o[16];
#pragma unroll
    for (int e = 0; e < 16; e++) {
      const float yn = (y[e] - mu) * rstd * lnw[c0 + e] + lnb[c0 + e];
      o[e] = (yn + bon * V[(size_t)t * 1024 + c0 + e]) * bf2f(G[(size_t)t * 1024 + c0 + e]);
    }
    u32x4 o0 = {pack2(o[0], o[1]), pack2(o[2], o[3]), pack2(o[4], o[5]), pack2(o[6], o[7])};
    u32x4 o1 = {pack2(o[8], o[9]), pack2(o[10], o[11]), pack2(o[12], o[13]), pack2(o[14], o[15])};
    *(u32x4*)&A2[(size_t)t * 2048 + c0] = o0; *(u32x4*)&A2[(size_t)t * 2048 + c0 + 8] = o1;
  }
}

template <int CTRL> DI unsigned dppu(unsigned x) { return (unsigned)__builtin_amdgcn_update_dpp(0, (int)x, CTRL, 0xf, 0xf, false); }
DI unsigned wave_max_u(unsigned v) {
  v = max(v, dppu<0xB1>(v)); v = max(v, dppu<0x4E>(v)); v = max(v, dppu<0x141>(v)); v = max(v, dppu<0x140>(v));
  const unsigned a = __builtin_amdgcn_readlane((int)v, 0), b = __builtin_amdgcn_readlane((int)v, 16), c = __builtin_amdgcn_readlane((int)v, 32), d = __builtin_amdgcn_readlane((int)v, 48);
  return max(max(a, b), max(c, d));
}
DI unsigned mkkey(float s, int idx) { unsigned u = __float_as_uint(s); u ^= (u >> 31) ? 0xffffffffu : 0x80000000u; return (u & ~0xffu) | (unsigned)(255 - idx); }
DI float keyval(unsigned k) { unsigned u = k & ~0xffu; u ^= (u >> 31) ? 0x80000000u : 0xffffffffu; return __uint_as_float(u); }
DI unsigned top16_keys2(unsigned k0, unsigned k1, int lane) {
  unsigned res = 0;
  for (int it = 0; it < 16; it++) {
    const unsigned m = wave_max_u(max(k0, k1));
    if (k0 == m) k0 = 0; if (k1 == m) k1 = 0;
    if (lane == it) res = m;
  }
  return res;
}
DI void topk_one(const bf16_t* __restrict__ s, int lane, int ci, int cj, bool cvalid, int& e_out, float& g_out) {
  const unsigned r1 = top16_keys2(mkkey(bf2f(s[lane]), lane), mkkey(bf2f(s[64 + lane]), 64 + lane), lane);
  const unsigned r2 = top16_keys2(mkkey(bf2f(s[128 + lane]), lane), mkkey(bf2f(s[192 + lane]), 64 + lane), lane);
  const float s1 = keyval(r1), s2 = keyval(r2);
  const int i1 = 255 - (int)(r1 & 0xffu), i2 = 255 - (int)(r2 & 0xffu);
  const float cand = __shfl(s1, ci) + __shfl(s2, cj);
  unsigned ck = cvalid ? mkkey(cand, lane) : 0u;
  unsigned rt = 0;
  for (int it = 0; it < 16; it++) {
    const unsigned m = wave_max_u(ck);
    if (ck == m) ck = 0;
    if (lane == it) rt = m;
  }
  const float tv = keyval(rt);
  const int cl = 255 - (int)(rt & 0xffu);
  const int wi = __shfl(ci, cl & 63), wj = __shfl(cj, cl & 63);
  const int e1 = __shfl(i1, wi), e2 = __shfl(i2, wj);
  const float mx = __shfl(tv, 0);
  const float ex = lane < 16 ? __expf(tv - mx) : 0.f;
  const float sum = wave_sum(ex);
  e_out = (e1 * 128 + e2) & 16383; g_out = ex / sum;
}

typedef float f2g __attribute__((ext_vector_type(2)));
struct GBuf { u32x4 u[2][2], v[2][2]; };
DI void phase_gather(const Params& p, int layer, char* lds) {
  const bf16_t* hm = (const bf16_t*)(p.ws + WS_HM);
  const unsigned char* ub = (const unsigned char*)(p.ws + WS_UB) + (size_t)layer * 16384 * 2048;
  const unsigned char* vb = (const unsigned char*)(p.ws + WS_VB) + (size_t)layer * 16384 * 2048;
  const float* usc = (const float*)(p.ws + WS_TSC) + layer * 16384;
  const float* vsc = (const float*)(p.ws + WS_TSC) + 32768 + layer * 16384;
  const bf16_t* sc = (const bf16_t*)(p.ws + WS_SC);
  const float* mod = (const float*)(p.ws + WS_MOD) + layer * 36864;
  float* xbuf = p.out; float* red = (float*)lds;
  const int tid = tid_(), lane = tid & 63, wave = tid >> 6;
  int ci = 0, cj = 0; bool cvalid = false;
  { int base = 0;
    for (int i = 0; i < 16; i++) { const int cnt = 16 / (i + 1); if (lane >= base && lane < base + cnt) { ci = i; cj = lane - base; cvalid = true; } base += cnt; } }
  const unsigned lo16 = (unsigned)lane * 16u;
  auto gl = [&](GBuf& b, int e_lanes, int g) {
#pragma unroll
    for (int jj = 0; jj < 2; jj++) {
      const unsigned e = (unsigned)__builtin_amdgcn_readlane(e_lanes, 2 * g + jj);
      const unsigned char* ur = ub + (size_t)e * 2048 + lo16; const unsigned char* vr = vb + (size_t)e * 2048 + lo16;
      b.u[jj][0] = *(const u32x4*)ur; b.u[jj][1] = *(const u32x4*)(ur + 1024);
      b.v[jj][0] = *(const u32x4*)vr; b.v[jj][1] = *(const u32x4*)(vr + 1024);
    }
  };
  int t = blockIdx.x;
  int e_l = 0; float g_l = 0.f;
  if (t < T) { topk_one(sc + ((size_t)t * 8 + wave) * 256, lane, ci, cj, cvalid, e_l, g_l); e_l = __shfl(e_l, lane & 15); g_l = __shfl(g_l, lane & 15); }
  GBuf A, B;
  if (t < T) gl(A, e_l, 0);
  for (; t < T; t += gridDim.x) {
    const int tn = t + gridDim.x < T ? t + gridDim.x : t;
    int e_n; float g_n;
    topk_one(sc + ((size_t)tn * 8 + wave) * 256, lane, ci, cj, cvalid, e_n, g_n); e_n = __shfl(e_n, lane & 15); g_n = __shfl(g_n, lane & 15);
    f2g x2[16];
#pragma unroll
    for (int hsel = 0; hsel < 2; hsel++)
#pragma unroll
      for (int c = 0; c < 2; c++) {
        const u32x4 u = *(const u32x4*)&hm[(size_t)t * 2048 + hsel * 1024 + lane * 16 + c * 8];
#pragma unroll
        for (int i = 0; i < 4; i++) x2[hsel * 8 + c * 4 + i] = f2g{lo2f(u[i]), hi2f(u[i])};
      }
    const float us_l = usc[e_l], vs_l = vsc[e_l];
    f2g acc2[16];
#pragma unroll
    for (int i = 0; i < 16; i++) acc2[i] = f2g{0.f, 0.f};
    auto comp = [&](GBuf& b, int g) {
      float coef[2];
#pragma unroll
      for (int jj = 0; jj < 2; jj++) {
        f2g d2 = {0.f, 0.f};
#pragma unroll
        for (int hsel = 0; hsel < 2; hsel++)
#pragma unroll
          for (int i = 0; i < 4; i++) {
            const f2g lo = __builtin_amdgcn_cvt_pk_f32_fp8((int)b.u[jj][hsel][i], false), hi = __builtin_amdgcn_cvt_pk_f32_fp8((int)b.u[jj][hsel][i], true);
            d2 = lo * x2[hsel * 8 + 2 * i] + d2; d2 = hi * x2[hsel * 8 + 2 * i + 1] + d2;
          }
        const float d = wave_sum(d2[0] + d2[1]) * rdlane(us_l, 2 * g + jj);
        coef[jj] = rdlane(g_l, 2 * g + jj) * rdlane(vs_l, 2 * g + jj) * 0.5f * d * (1.f + erff(d * 0.70710678118654752f));
      }
#pragma unroll
      for (int jj = 0; jj < 2; jj++) {
        const f2g c2 = {coef[jj], coef[jj]};
#pragma unroll
        for (int hsel = 0; hsel < 2; hsel++)
#pragma unroll
          for (int i = 0; i < 4; i++) {
            const f2g lo = __builtin_amdgcn_cvt_pk_f32_fp8((int)b.v[jj][hsel][i], false), hi = __builtin_amdgcn_cvt_pk_f32_fp8((int)b.v[jj][hsel][i], true);
            acc2[hsel * 8 + 2 * i] = c2 * lo + acc2[hsel * 8 + 2 * i]; acc2[hsel * 8 + 2 * i + 1] = c2 * hi + acc2[hsel * 8 + 2 * i + 1];
          }
      }
    };
#pragma unroll 1
    for (int g = 0; g < 8; g += 2) {
      gl(B, e_l, g + 1);
      __builtin_amdgcn_sched_barrier(0);
      comp(A, g);
      __builtin_amdgcn_sched_barrier(0);
      if (g + 2 < 8) gl(A, e_l, g + 2); else gl(A, e_n, 0);
      __builtin_amdgcn_sched_barrier(0);
      comp(B, g + 1);
      __builtin_amdgcn_sched_barrier(0);
    }
    e_l = e_n; g_l = g_n;
#pragma unroll
    for (int hsel = 0; hsel < 2; hsel++)
#pragma unroll
      for (int i = 0; i < 4; i++) {
        const float4 a4 = {acc2[hsel * 8 + 2 * i][0], acc2[hsel * 8 + 2 * i][1], acc2[hsel * 8 + 2 * i + 1][0], acc2[hsel * 8 + 2 * i + 1][1]};
        *(float4*)&red[wave * 2048 + hsel * 1024 + lane * 16 + i * 4] = a4;
      }
    __syncthreads();
    {
      const int n = tid * 4;
      float4 sm = *(float4*)&red[n];
#pragma unroll
      for (int w = 1; w < 8; w++) { const float4 a = *(float4*)&red[w * 2048 + n]; sm.x += a.x; sm.y += a.y; sm.z += a.z; sm.w += a.w; }
      const float4 gt = *(const float4*)&mod[cvec_of(t) * 12288 + 5 * 2048 + n];
      float4 xo = *(float4*)&xbuf[(size_t)t * 2048 + n];
      xo.x += gt.x * sm.x; xo.y += gt.y * sm.y; xo.z += gt.z * sm.z; xo.w += gt.w * sm.w;
      *(float4*)&xbuf[(size_t)t * 2048 + n] = xo;
      if (layer == 0) {
        const float ss = wave_sum(xo.x * xo.x + xo.y * xo.y + xo.z * xo.z + xo.w * xo.w);
        __syncthreads();
        if (lane == 0) red[wave] = ss;
        __syncthreads();
        float tot = 0.f;
#pragma unroll
        for (int w = 0; w < 8; w++) tot += red[w];
        const float rstd = rsqrtf(tot * (1.f / 2048.f) + 1e-6f);
        const float* m1 = (const float*)(p.ws + WS_MOD) + 36864 + cvec_of(t) * 12288;
        const float4 g = *(const float4*)&p.in[IN_NORM1][2048 + n], sc1 = *(const float4*)&m1[2048 + n], sh1 = *(const float4*)&m1[n];
        const u32x2 o = {pack2(xo.x * rstd * g.x * (1.f + sc1.x) + sh1.x, xo.y * rstd * g.y * (1.f + sc1.y) + sh1.y),
                         pack2(xo.z * rstd * g.z * (1.f + sc1.z) + sh1.z, xo.w * rstd * g.w * (1.f + sc1.w) + sh1.w)};
        *(u32x2*)((bf16_t*)(p.ws + WS_HM) + (size_t)t * 2048 + n) = o;
      }
    }
    __syncthreads();
  }
}

DI float2 cmul(float2 a, float2 b) { return make_float2(a.x * b.x - a.y * b.y, a.x * b.y + a.y * b.x); }
DI int PI(int p) { return p + ((p >> 5) << 3); }
DI float2 cadd(float2 a, float2 b) { return make_float2(a.x + b.x, a.y + b.y); }
DI float2 csub(float2 a, float2 b) { return make_float2(a.x - b.x, a.y - b.y); }
DI float2 cmulc(float2 a, float2 b) { return make_float2(a.x * b.x + a.y * b.y, a.y * b.x - a.x * b.y); }
typedef float c2 __attribute__((ext_vector_type(2)));
DI c2 cm(c2 a, c2 t, c2 ts) { return c2{a[0], a[0]} * t + c2{a[1], a[1]} * ts; }
DI void fft_dif(float2* buf_, const float2* tw_, int n) {
  c2* buf = (c2*)buf_; const c2* tw = (const c2*)tw_;
  const int tid = tid_();
  for (int h = n >> 1; h >= 4; h >>= 2) {
    const int q = h >> 1;
    if (q <= 512) {
      const int j = tid & (q - 1), base = ((tid - j) << 2) + j;
      const int a0 = PI(base), a1 = PI(base + q), a2 = PI(base + 2 * q), a3 = PI(base + 3 * q);
      const c2 t = tw[h + j], t2 = tw[q + j], ts = {-t[1], t[0]}, t2s = {-t2[1], t2[0]};
#pragma unroll
      for (int r = 0; r < 4; r++) {
        const int o = r * 2560;
        const c2 x0 = buf[a0 + o], x1 = buf[a1 + o], x2 = buf[a2 + o], x3 = buf[a3 + o];
        const c2 a02 = x0 + x2, s02 = x0 - x2, a13 = x1 + x3, s13 = x1 - x3;
        const c2 u2 = cm(s02, t, ts), m = cm(s13, t, ts), u3 = {m[1], -m[0]};
        buf[a0 + o] = a02 + a13; buf[a1 + o] = cm(a02 - a13, t2, t2s);
        buf[a2 + o] = u2 + u3;   buf[a3 + o] = cm(u2 - u3, t2, t2s);
      }
    } else {
#pragma unroll
      for (int r = 0; r < 4; r++) {
        const int i = tid + r * 512, j = i & (q - 1), base = ((i - j) << 2) + j;
        const int a0 = PI(base), a1 = PI(base + q), a2 = PI(base + 2 * q), a3 = PI(base + 3 * q);
        const c2 t = tw[h + j], t2 = tw[q + j], ts = {-t[1], t[0]}, t2s = {-t2[1], t2[0]};
        const c2 x0 = buf[a0], x1 = buf[a1], x2 = buf[a2], x3 = buf[a3];
        const c2 a02 = x0 + x2, s02 = x0 - x2, a13 = x1 + x3, s13 = x1 - x3;
        const c2 u2 = cm(s02, t, ts), m = cm(s13, t, ts), u3 = {m[1], -m[0]};
        buf[a0] = a02 + a13; buf[a1] = cm(a02 - a13, t2, t2s);
        buf[a2] = u2 + u3;   buf[a3] = cm(u2 - u3, t2, t2s);
      }
    }
    __syncthreads();
  }
#pragma unroll
  for (int r = 0; r < 8; r++) {
    const int a = PI(2 * (tid + r * 512));
    const float4 v = *(const float4*)&buf[a];
    *(float4*)&buf[a] = make_float4(v.x + v.z, v.y + v.w, v.x - v.z, v.y - v.w);
  }
  __syncthreads();
}
DI void fft_dit_inv(float2* buf_, const float2* tw_, int n) {
  c2* buf = (c2*)buf_; const c2* tw = (const c2*)tw_;
  const int tid = tid_();
#pragma unroll
  for (int r = 0; r < 8; r++) {
    const int a = PI(2 * (tid + r * 512));
    const float4 v = *(const float4*)&buf[a];
    *(float4*)&buf[a] = make_float4(v.x + v.z, v.y + v.w, v.x - v.z, v.y - v.w);
  }
  __syncthreads();
  for (int h = 4; h <= (n >> 1); h <<= 2) {
    const int q = h >> 1;
    if (q <= 512) {
      const int j = tid & (q - 1), base = ((tid - j) << 2) + j;
      const int a0 = PI(base), a1 = PI(base + q), a2 = PI(base + 2 * q), a3 = PI(base + 3 * q);
      const c2 tt = tw[h + j], tt2 = tw[q + j];
      const c2 t = {tt[0], -tt[1]}, ts = {tt[1], tt[0]}, t2 = {tt2[0], -tt2[1]}, t2s = {tt2[1], tt2[0]};
#pragma unroll
      for (int r = 0; r < 4; r++) {
        const int o = r * 2560;
        const c2 y0 = buf[a0 + o], y1 = buf[a1 + o], y2 = buf[a2 + o], y3 = buf[a3 + o];
        const c2 v1 = cm(y1, t2, t2s), v3 = cm(y3, t2, t2s);
        const c2 u0 = y0 + v1, u1 = y0 - v1, u2 = y2 + v3, u3 = y2 - v3;
        const c2 w2 = cm(u2, t, ts), m = cm(u3, t, ts), w3 = {-m[1], m[0]};
        buf[a0 + o] = u0 + w2; buf[a2 + o] = u0 - w2; buf[a1 + o] = u1 + w3; buf[a3 + o] = u1 - w3;
      }
    } else {
#pragma unroll
      for (int r = 0; r < 4; r++) {
        const int i = tid + r * 512, j = i & (q - 1), base = ((i - j) << 2) + j;
        const int a0 = PI(base), a1 = PI(base + q), a2 = PI(base + 2 * q), a3 = PI(base + 3 * q);
        const c2 tt = tw[h + j], tt2 = tw[q + j];
        const c2 t = {tt[0], -tt[1]}, ts = {tt[1], tt[0]}, t2 = {tt2[0], -tt2[1]}, t2s = {tt2[1], tt2[0]};
        const c2 y0 = buf[a0], y1 = buf[a1], y2 = buf[a2], y3 = buf[a3];
        const c2 v1 = cm(y1, t2, t2s), v3 = cm(y3, t2, t2s);
        const c2 u0 = y0 + v1, u1 = y0 - v1, u2 = y2 + v3, u3 = y2 - v3;
        const c2 w2 = cm(u2, t, ts), m = cm(u3, t, ts), w3 = {-m[1], m[0]};
        buf[a0] = u0 + w2; buf[a2] = u0 - w2; buf[a1] = u1 + w3; buf[a3] = u1 - w3;
      }
    }
    __syncthreads();
  }
}
DI float conv3_row(const bf16_t* __restrict__ row, int tl, int L, float w0, float w1, float w2, float b) {
  float v = bf2f(row[0]) * w1 + b;
  if (tl > 0) v += bf2f(row[-1]) * w0;
  if (tl < L - 1) v += bf2f(row[1]) * w2;
  return v;
}
template <int L>
DI void hyena_item(const Params& p, int c, float2* buf, const float2* tw, float* sred) {
  constexpr int N = 2 * L, NPOS = (L == 4096) ? 8 : 16;
  constexpr int NTAP = (L == 4096) ? 8 : 1;
  const int tid = tid_();
  const bool act = (L == 4096) ? true : (tid < 256);
  const bf16_t* ut = (const bf16_t*)(p.ws + WS_UT);
  bf16_t* z2t = (bf16_t*)(p.ws + WS_Z2T);
  const float* cw = p.in[IN_OC_CONV]; const float* cb = p.in[IN_OC_CONVB]; const float* bias = p.in[IN_OC_BIAS];
  float hf[2][2][NTAP];
  {
    const bf16_t* filt = (const bf16_t*)(p.ws + WS_FILT) + (L == 4096 ? 256 : 0);
    const float delta = fabsf(-3.0701134573253945f + (float)c * ((-15.350567286626973f + 3.0701134573253945f) / 2047.f));
    float ssq0 = 0.f, ssq1 = 0.f;
#pragma unroll
    for (int i = 0; i < NTAP; i++) {
      const int tt = tid + 512 * i;
      float a00 = 0.f, a01 = 0.f, a10 = 0.f, a11 = 0.f;
      if (tt < L) {
        const float dec = __expf(-((float)tt / (float)(L - 1)) * delta);
        a00 = bf2f(filt[(size_t)(0 * 2048 + c) * 4352 + tt]) * dec; a01 = bf2f(filt[(size_t)(1 * 2048 + c) * 4352 + tt]) * dec;
        a10 = bf2f(filt[(size_t)(2 * 2048 + c) * 4352 + tt]) * dec; a11 = bf2f(filt[(size_t)(3 * 2048 + c) * 4352 + tt]) * dec;
      }
      hf[0][0][i] = a00; hf[0][1][i] = a01; hf[1][0][i] = a10; hf[1][1][i] = a11;
      ssq0 += a00 * a00 + a01 * a01; ssq1 += a10 * a10 + a11 * a11;
    }
    __syncthreads();
    ssq0 = wave_sum(ssq0); ssq1 = wave_sum(ssq1);
    if ((tid & 63) == 0) { sred[(tid >> 6) * 2] = ssq0; sred[(tid >> 6) * 2 + 1] = ssq1; }
    __syncthreads();
    float t0 = 0.f, t1 = 0.f;
#pragma unroll
    for (int w = 0; w < 8; w++) { t0 += sred[w * 2]; t1 += sred[w * 2 + 1]; }
    const float sc0 = rsqrtf(t0 + 1e-12f), sc1 = rsqrtf(t1 + 1e-12f);
#pragma unroll
    for (int i = 0; i < NTAP; i++) { hf[0][0][i] *= sc0; hf[0][1][i] *= sc0; hf[1][0][i] *= sc1; hf[1][1][i] *= sc1; }
  }
  auto tok_of = [&](int i, int m) -> size_t {
    if (L == 4096) return (size_t)TP + (size_t)m * 4096 + tid + 512 * i;
    return (size_t)(2 * i + m) * 256 + tid;
  };
  auto tl_of = [&](int i) -> int { return (L == 4096) ? tid + 512 * i : tid; };
  float zin[NPOS][2];
  const float inv_n = 1.f / (float)N;
#pragma unroll
  for (int o = 0; o < 2; o++) {
    __syncthreads();
#pragma unroll
    for (int i = 0; i < NTAP; i++) {
      const int tt = tid + 512 * i;
      if (tt < L) {
        for (int seg = 0; seg < 8192 / N; seg++) {
          buf[PI(seg * N + tt)] = make_float2(hf[o][0][i], 0.f);
          if (tt >= 1) buf[PI(seg * N + N - tt)] = make_float2(hf[o][1][i], 0.f); else buf[PI(seg * N + L)] = make_float2(0.f, 0.f);
        }
      }
    }
    __syncthreads();
    fft_dif(buf, tw, N);
    float2 F[16];
#pragma unroll
    for (int i = 0; i < 16; i++) F[i] = buf[PI(tid + 512 * i)];
    __syncthreads();
    if (o == 0) {
      const float w0 = cw[4096 + c], w1 = cw[6144 + 4096 + c], w2 = cw[12288 + 4096 + c], bb = cb[4096 + c];
#pragma unroll
      for (int i = 0; i < NPOS; i++)
#pragma unroll
        for (int m = 0; m < 2; m++)
          zin[i][m] = act ? conv3_row(ut + (size_t)(4096 + c) * T + tok_of(i, m), tl_of(i), L, w0, w1, w2, bb) : 0.f;
    }
#pragma unroll
    for (int i = 0; i < 16; i++) {
      const int pp = tid + 512 * i;
      float2 val = make_float2(0.f, 0.f);
      if (L == 4096) { if (i < 8) val = make_float2(zin[i < 8 ? i : 0][0], zin[i < 8 ? i : 0][1]); }
      else { if (act) val = make_float2(zin[i % NPOS][0], zin[i % NPOS][1]); }
      buf[PI(pp)] = val;
    }
    __syncthreads();
    fft_dif(buf, tw, N);
#pragma unroll
    for (int i = 0; i < 16; i++) { const int pp = PI(tid + 512 * i); buf[pp] = cmul(buf[pp], F[i]); }
    __syncthreads();
    fft_dit_inv(buf, tw, N);
    {
      const int gcol = o * 2048 + c;
      const float w0 = cw[gcol], w1 = cw[6144 + gcol], w2 = cw[12288 + gcol], bb = cb[gcol];
      const float bo = bias[o * 2048 + c];
#pragma unroll
      for (int i = 0; i < NPOS; i++) {
        const int pp = (L == 4096) ? tid + 512 * i : i * 512 + tid;
        const float2 cv = buf[PI(pp)];
#pragma unroll
        for (int m = 0; m < 2; m++) {
          if (act) {
            const float gate = conv3_row(ut + (size_t)gcol * T + tok_of(i, m), tl_of(i), L, w0, w1, w2, bb);
            const float conv = (m == 0 ? cv.x : cv.y) * inv_n;
            zin[i][m] = gate * (conv + bo * zin[i][m]);
          }
        }
      }
    }
  }
  if (act) {
#pragma unroll
    for (int i = 0; i < NPOS; i++)
#pragma unroll
      for (int m = 0; m < 2; m++) z2t[(size_t)c * T + tok_of(i, m)] = f2bf(zin[i][m]);
  }
}
template <int L>
DI void hyena_item_mfma(const Params& p, int c, char* lds, float* sred) {
  constexpr int NTAP = (L == 4096) ? 8 : 1;
  constexpr int GN = 2 * L, GS = GN + 32, RS = 264;
  const int tid = tid_(), lane = tid & 63, wave = tid >> 6, r32 = lane & 31, h = lane >> 5;
  const size_t tokbase = (L == 4096) ? (size_t)TP : 0;
  bf16_t* G = (bf16_t*)lds;
  bf16_t* ub = (bf16_t*)(lds + 66560); bf16_t* zb = ub + 32 * RS; bf16_t* x1b = zb + 32 * RS; bf16_t* x2b = x1b + 32 * RS; bf16_t* zeros = x2b + 32 * RS;
  const bf16_t* ut = (const bf16_t*)(p.ws + WS_UT);
  bf16_t* z2t = (bf16_t*)(p.ws + WS_Z2T);
  const float* cw = p.in[IN_OC_CONV]; const float* cb = p.in[IN_OC_CONVB]; const float* bias = p.in[IN_OC_BIAS];
  float hf[2][2][NTAP];
  {
    const bf16_t* filt = (const bf16_t*)(p.ws + WS_FILT) + (L == 4096 ? 256 : 0);
    const float delta = fabsf(-3.0701134573253945f + (float)c * ((-15.350567286626973f + 3.0701134573253945f) / 2047.f));
    float ssq0 = 0.f, ssq1 = 0.f;
#pragma unroll
    for (int i = 0; i < NTAP; i++) {
      const int tt = tid + 512 * i;
      float a00 = 0.f, a01 = 0.f, a10 = 0.f, a11 = 0.f;
      if (tt < L) {
        const float dec = __expf(-((float)tt / (float)(L - 1)) * delta);
        a00 = bf2f(filt[(size_t)(0 * 2048 + c) * 4352 + tt]) * dec; a01 = bf2f(filt[(size_t)(1 * 2048 + c) * 4352 + tt]) * dec;
        a10 = bf2f(filt[(size_t)(2 * 2048 + c) * 4352 + tt]) * dec; a11 = bf2f(filt[(size_t)(3 * 2048 + c) * 4352 + tt]) * dec;
      }
      hf[0][0][i] = a00; hf[0][1][i] = a01; hf[1][0][i] = a10; hf[1][1][i] = a11;
      ssq0 += a00 * a00 + a01 * a01; ssq1 += a10 * a10 + a11 * a11;
    }
    __syncthreads();
    ssq0 = wave_sum(ssq0); ssq1 = wave_sum(ssq1);
    if (lane == 0) { sred[wave * 2] = ssq0; sred[wave * 2 + 1] = ssq1; }
    __syncthreads();
    float t0 = 0.f, t1 = 0.f;
#pragma unroll
    for (int w = 0; w < 8; w++) { t0 += sred[w * 2]; t1 += sred[w * 2 + 1]; }
    const float sc0 = rsqrtf(t0 + 1e-12f), sc1 = rsqrtf(t1 + 1e-12f);
#pragma unroll
    for (int i = 0; i < NTAP; i++) { hf[0][0][i] *= sc0; hf[0][1][i] *= sc0; hf[1][0][i] *= sc1; hf[1][1][i] *= sc1; }
  }
#pragma unroll
  for (int o = 0; o < 2; o++) {
    bf16_t* c0 = G + (o * 2 + 0) * GS; bf16_t* c1 = G + (o * 2 + 1) * GS;
#pragma unroll
    for (int i = 0; i < NTAP; i++) {
      const int tt = tid + 512 * i;
      if (tt < L) {
        const bf16_t f = f2bf(hf[o][0][i]), bw = f2bf(hf[o][1][i]);
        const int i_f = L - 1 - tt;
        c0[i_f] = f; if (i_f >= 1) c1[i_f - 1] = f;
        if (tt >= 1) { const int i_b = L - 1 + tt; c0[i_b] = bw; c1[i_b - 1] = bw; }
      }
    }
    if (tid == 0) { c0[2 * L - 1] = 0; c1[2 * L - 2] = 0; c1[2 * L - 1] = 0; }
  }
  if (tid < 128) ((unsigned*)zeros)[tid] = 0u;
  auto load_conv = [&](int rowsel, bf16_t* dst) {
    const bf16_t* src = ut + (size_t)rowsel * T + tokbase + 16 * tid;
    float f[18];
    unpack8(*(const u32x4*)src, f + 1); unpack8(*(const u32x4*)(src + 8), f + 9);
    const int pos = (16 * tid) & (L - 1);
    f[0] = pos > 0 ? bf2f(src[-1]) : 0.f; f[17] = pos + 16 < L ? bf2f(src[16]) : 0.f;
    const float w0 = cw[rowsel], w1 = cw[6144 + rowsel], w2 = cw[12288 + rowsel], bb = cb[rowsel];
    float o[16];
#pragma unroll
    for (int e = 0; e < 16; e++) o[e] = f[e] * w0 + f[e + 1] * w1 + f[e + 2] * w2 + bb;
    const u32x4 o0 = {pack2(o[0], o[1]), pack2(o[2], o[3]), pack2(o[4], o[5]), pack2(o[6], o[7])};
    const u32x4 o1 = {pack2(o[8], o[9]), pack2(o[10], o[11]), pack2(o[12], o[13]), pack2(o[14], o[15])};
    bf16_t* d = dst + (tid >> 4) * RS + (tid & 15) * 16;
    *(u32x4*)d = o0; *(u32x4*)(d + 8) = o1;
  };
  load_conv(4096 + c, ub); load_conv(c, x1b); load_conv(2048 + c, x2b);
  __syncthreads();
  auto conv = [&](int o, const bf16_t* bsrc) -> f32x16 {
    f32x16 acc;
#pragma unroll
    for (int r = 0; r < 16; r++) acc[r] = 0.f;
    const int par = (r32 & 1) ^ 1;
    const unsigned* gc = (const unsigned*)(G + (o * 2 + par) * GS);
    const int i00 = L - 1 - 32 * wave - r32 + 8 * h;
    u32x4 cur[16];
    auto loadB = [&]() {
#pragma unroll
      for (int kb = 0; kb < 16; kb++) cur[kb] = *(const u32x4*)(bsrc + r32 * RS + 8 * h + 16 * kb);
    };
    auto mm = [&](int m) {
      const unsigned* gp = gc + ((i00 - 256 * m - par) >> 1);
#pragma unroll
      for (int kb = 0; kb < 16; kb++) {
        const u32x4 av = {gp[8 * kb], gp[8 * kb + 1], gp[8 * kb + 2], gp[8 * kb + 3]};
        acc = __builtin_amdgcn_mfma_f32_32x32x16_bf16(__builtin_bit_cast(bf16x8, av), __builtin_bit_cast(bf16x8, cur[kb]), acc, 0, 0, 0);
      }
    };
    loadB(); mm(0);
    if constexpr (L == 4096) {
#pragma unroll 1
      for (int m = 1; m <= 15; m++) {
#pragma unroll
        for (int kb = 0; kb < 16; kb++)
#pragma unroll
          for (int e = 0; e < 4; e++) cur[kb][e] = (unsigned)__builtin_amdgcn_update_dpp(0, (int)cur[kb][e], 0x111, 0xf, 0xf, true);
        mm(m);
      }
      loadB();
#pragma unroll 1
      for (int m = -1; m >= -15; m--) {
#pragma unroll
        for (int kb = 0; kb < 16; kb++)
#pragma unroll
          for (int e = 0; e < 4; e++) cur[kb][e] = (unsigned)__builtin_amdgcn_update_dpp(0, (int)cur[kb][e], 0x101, 0xf, 0xf, true);
        mm(m);
      }
    }
    return acc;
  };
  auto gate = [&](const f32x16& acc, const bf16_t* uin, const bf16_t* gt, float bo, bf16_t* dst) {
#pragma unroll
    for (int k = 0; k < 4; k++) {
      const int idx = r32 * RS + 32 * wave + 8 * k + 4 * h;
      const u32x2 uu = *(const u32x2*)(uin + idx), gg = *(const u32x2*)(gt + idx);
      const float u0 = lo2f(uu[0]), u1 = hi2f(uu[0]), u2 = lo2f(uu[1]), u3 = hi2f(uu[1]);
      const float g0 = lo2f(gg[0]), g1 = hi2f(gg[0]), g2 = lo2f(gg[1]), g3 = hi2f(gg[1]);
      const u32x2 ov = {pack2(g0 * (acc[4 * k] + bo * u0), g1 * (acc[4 * k + 1] + bo * u1)), pack2(g2 * (acc[4 * k + 2] + bo * u2), g3 * (acc[4 * k + 3] + bo * u3))};
      *(u32x2*)(dst + idx) = ov;
    }
  };
  { const f32x16 a0 = conv(0, ub); gate(a0, ub, x1b, bias[c], zb); }
  __syncthreads();
  { const f32x16 a1 = conv(1, zb); gate(a1, zb, x2b, bias[2048 + c], ub); }
  __syncthreads();
  { bf16_t* dstp = z2t + (size_t)c * T + tokbase + 16 * tid;
    const bf16_t* sp = ub + (tid >> 4) * RS + (tid & 15) * 16;
    *(u32x4*)dstp = *(const u32x4*)sp; *(u32x4*)(dstp + 8) = *(const u32x4*)(sp + 8); }
}
DI void phase_hyena_mfma(const Params& p, char* lds) {
  __shared__ float sred_m[32];
  for (int it = blockIdx.x; it < 4096; it += gridDim.x) {
    if (it < 2048) hyena_item_mfma<4096>(p, it, lds, sred_m);
    else hyena_item_mfma<256>(p, it - 2048, lds, sred_m);
  }
}
DI void phase_hyena(const Params& p, char* lds) {
  float2* buf = (float2*)lds; float2* tw = (float2*)(lds + 81920);
  __shared__ float sred_s[32 + 256];
  for (int k = tid_(); k < 8192; k += NTH) {
    if (k >= 1) { const int half = 1 << (31 - __clz(k)); float s, c; sincospif((float)(k - half) / (float)half, &s, &c); tw[k] = make_float2(c, -s); }
  }
  __syncthreads();
  for (int it = blockIdx.x; it < 4096; it += gridDim.x) {
    if (it < 2048) hyena_item<4096>(p, it, buf, tw, sred_s);
    else hyena_item<256>(p, it - 2048, buf, tw, sred_s);
  }
}
DI void phase_transpose_z2(const Params& p, char* lds) {
  const bf16_t* src = (const bf16_t*)(p.ws + WS_Z2T); bf16_t* dst = (bf16_t*)(p.ws + WS_HM);
  bf16_t* tile = (bf16_t*)lds;
  const int tid = tid_();
  for (int tI = blockIdx.x; tI < 32 * 256; tI += gridDim.x) {
    const int c0 = (tI >> 8) * 64, t0 = (tI & 255) * 64;
    { const int r = tid >> 3, ch = tid & 7;
      *(u32x4*)&tile[r * 72 + ch * 8] = *(const u32x4*)&src[(size_t)(c0 + r) * T + t0 + ch * 8]; }
    __syncthreads();
    { const int tt = tid >> 3, cc = tid & 7;
      unsigned short v[8];
#pragma unroll
      for (int j = 0; j < 8; j++) v[j] = tile[(cc * 8 + j) * 72 + tt];
      u32x4 o = {(unsigned)v[0] | ((unsigned)v[1] << 16), (unsigned)v[2] | ((unsigned)v[3] << 16), (unsigned)v[4] | ((unsigned)v[5] << 16), (unsigned)v[6] | ((unsigned)v[7] << 16)};
      *(u32x4*)&dst[(size_t)(t0 + tt) * 2048 + c0 + cc * 8] = o; }
    __syncthreads();
  }
}

DI void peer_block(const Params& p, int layer, const XcdBarrier& xb, char* lds) {
  const float* mod = (const float*)(p.ws + WS_MOD) + layer * 36864;
  bf16_t* hm = (bf16_t*)(p.ws + WS_HM);
  phase_norm(p.out, p.out + (size_t)TP * 2048, p.in[IN_NORM2] + layer * 2048, mod, 3 * 2048, 4 * 2048, hm);
  xcd_barrier(xb);
  { EpiBF16 e{(bf16_t*)(p.ws + WS_PQ), 2048};
    gemm_full<256>(hm, 2048, (const bf16_t*)(p.ws + WS_WT_Q) + (size_t)layer * 2048 * 2048, 2048, T, 2048, 2048, e, lds); }
  xcd_barrier(xb);
  {
    EpiBF16 e{(bf16_t*)(p.ws + WS_SC), 2048};
    const bf16_t* q = (const bf16_t*)(p.ws + WS_PQ); const bf16_t* keys = (const bf16_t*)(p.ws + WS_KEYS) + (size_t)layer * 2048 * 128;
    for (int tile = blockIdx.x; tile < 64 * 16; tile += gridDim.x) {
      const int g = tile & 15, mt = tile >> 4;
      gemm_tile<128>(q + g * 128, 2048, keys, 128, mt * 256, g * 128, 2048, 128, e, lds);
    }
  }
  xcd_barrier(xb);
  phase_gather(p, layer, lds);
  xcd_barrier(xb);
}

__global__ void __launch_bounds__(NTH) fwd_megakernel(Params p) {
  cg::grid_group grid = cg::this_grid();
  __shared__ __attribute__((aligned(16))) char lds[LDS_BYTES];
  float* mod = (float*)(p.ws + WS_MOD);
  bf16_t* hm = (bf16_t*)(p.ws + WS_HM);

  __shared__ uint4 xb_words;
  unsigned* bar = (unsigned*)(p.ws + WS_BAR);
  if (tid_() == 0) xb_words = make_uint4(0u, 0u, 0u, 0u);
  if (blockIdx.x == 0) for (int i = tid_(); i < XCD_BAR_WORDS; i += NTH) bar[i] = 0u;
  transpose_tiles(p.in[IN_EW_IN], (bf16_t*)(p.ws + WS_WT_IN0), 2048, ZC, (float*)lds);
  for (int d = 0; d < 2; d++) {
    transpose_tiles(p.in[IN_EA_WU] + d * 65536, (bf16_t*)(p.ws + WS_WU_T) + d * 65536, 64, 1024, (float*)lds);
    transpose_tiles(p.in[IN_EA_AU] + d * 65536, (bf16_t*)(p.ws + WS_AU_T) + d * 65536, 64, 1024, (float*)lds);
  }
  transpose_tiles(p.in[IN_EA_GU], (bf16_t*)(p.ws + WS_GU_T), 128, 1024, (float*)lds);
  convert_bf16(p.in[IN_PEER_KEYS], (bf16_t*)(p.ws + WS_KEYS), (size_t)2 * 2048 * 128 / 8);
  phase_mod_partial(p);
  phase_hdn2(p);
  grid.sync();
  const XcdBarrier xb = xcd_barrier_post(bar, (volatile LAS unsigned*)&xb_words);
  phase_mod_reduce(p);
  xcd_barrier(xb);
  phase_norm(p.in[IN_X_PROMPT], p.in[IN_X_SAMPLE], p.in[IN_NORM1], mod, 0, 2048, hm);
  xcd_barrier(xb);
  { EpiBF16 e{(bf16_t*)(p.ws + WS_Z0), ZC};
    gemm_full<256>(hm, 2048, (const bf16_t*)(p.ws + WS_WT_IN0), 2048, T, ZC, 2048, e, lds); }
  xcd_barrier(xb);
  phase_prep0(p, lds);
  xcd_barrier(xb);
  {
    const bf16_t* Qb = (const bf16_t*)(p.ws + WS_QB); bf16_t* A2 = (bf16_t*)(p.ws + WS_A2);
    for (int it = blockIdx.x; it < 512; it += gridDim.x) {
      __syncthreads();
      size_t row0, kvoff; int h, seq; const bf16_t *Kb, *Vb;
      if (it < 256) {
        const int b = it >> 7, qb = it & 15; h = (it >> 4) & 7;
        row0 = (size_t)TP + (size_t)b * 4096 + qb * 256; kvoff = (size_t)b * SKV_S * 256; seq = SKV_S;
        Kb = (const bf16_t*)(p.ws + WS_KBS); Vb = (const bf16_t*)(p.ws + WS_VBS);
      } else {
        const int i = it - 256, b = i >> 3; h = i & 7;
        row0 = (size_t)b * 256; kvoff = row0 * 256; seq = 256;
        Kb = (const bf16_t*)(p.ws + WS_KBP); Vb = (const bf16_t*)(p.ws + WS_VBP);
      }
      attn_dense_body<1024, 256, 2048>(Qb + row0 * 1024 + h * 128, Kb + kvoff + (h >> 2) * 128, Vb + kvoff + (h >> 2) * 128,
                                       A2 + row0 * 2048 + 1024 + h * 128, seq, lds);
    }
    __syncthreads();
    const bf16_t* actA = (const bf16_t*)(p.ws + WS_ACTA);
    for (int d = 0; d < 2; d++) {
      EpiW ew{(float*)(p.ws + WS_W), p.in[IN_EA_W0], d};
      gemm_full<256>(actA + d * 64, 384, (const bf16_t*)(p.ws + WS_WU_T) + d * 65536, 64, T, 1024, 64, ew, lds);
      EpiA ea{(bf16_t*)(p.ws + WS_UB), p.in[IN_EA_A0], d};
      gemm_full<256>(actA + 128 + d * 64, 384, (const bf16_t*)(p.ws + WS_AU_T) + d * 65536, 64, T, 1024, 64, ea, lds);
    }
    EpiBF16 eg{(bf16_t*)(p.ws + WS_G), 1024};
    gemm_full<256>(actA + 256, 384, (const bf16_t*)(p.ws + WS_GU_T), 128, T, 1024, 128, eg, lds);
  }
  xcd_barrier(xb);
  phase_fixa(p);
  xcd_barrier(xb);
  phase_scan(p, lds);
  xcd_barrier(xb);
  phase_post0(p);
  xcd_barrier(xb);
  { EpiRes e{p.in[IN_X_PROMPT], p.in[IN_X_SAMPLE], mod + 2 * 2048, p.out};
    gemm_full<256>((const bf16_t*)(p.ws + WS_A2), 2048, (const bf16_t*)(p.ws + WS_WT_OUT0), 2048, T, 2048, 2048, e, lds); }
  xcd_barrier(xb);
  peer_block(p, 0, xb, lds);
  { EpiBF16 e{(bf16_t*)(p.ws + WS_UT), (size_t)T};
    gemm_full<256>((const bf16_t*)(p.ws + WS_WT_IN1), 2048, hm, 2048, 6144, T, 2048, e, lds); }
  { EpiBF16 e{(bf16_t*)(p.ws + WS_FILT), 4352};
    gemm_full<256>((const bf16_t*)(p.ws + WS_FW3T), 64, (const bf16_t*)(p.ws + WS_HDN2B), 64, 8192, 4352, 64, e, lds); }
  xcd_barrier(xb);
  phase_hyena_mfma(p, lds);
  xcd_barrier(xb);
  phase_transpose_z2(p, lds);
  xcd_barrier(xb);
  { EpiRes e{p.out, p.out + (size_t)TP * 2048, mod + 36864 + 2 * 2048, p.out};
    gemm_full<256>(hm, 2048, (const bf16_t*)(p.ws + WS_WT_OUT1), 2048, T, 2048, 2048, e, lds); }
  xcd_barrier(xb);
  peer_block(p, 1, xb, lds);
}

extern "C" void kernel_launch(void* const* d_in, const int* in_sizes, int n_in, void* d_out, int out_size, void* d_ws, size_t ws_size, hipStream_t stream) {
  static int grid_blocks = 0;
  if (!grid_blocks) {
    int dev = 0, cus = 0, per_cu = 0;
    hipGetDevice(&dev);
    hipDeviceGetAttribute(&cus, hipDeviceAttributeMultiprocessorCount, dev);
    hipOccupancyMaxActiveBlocksPerMultiprocessor(&per_cu, fwd_megakernel, NTH, 0);
    if (per_cu < 1) per_cu = 1;
    if (per_cu > 1) per_cu = 1;
    grid_blocks = cus * per_cu;
  }
  if (n_in != N_IN || ws_size < WS_END2) { fprintf(stderr, "kernel_launch: bad n_in %d or ws_size %zu < %zu\n", n_in, ws_size, (size_t)WS_END); return; }
  Params p{};
  for (int i = 0; i < N_IN; i++) p.in[i] = (const float*)d_in[i];
  p.out = (float*)d_out; p.ws = (char*)d_ws;
  void* args[] = {&p};
  hipError_t e = hipLaunchCooperativeKernel((void*)fwd_megakernel, dim3(grid_blocks), dim3(NTH), args, 0, stream);
  if (e != hipSuccess) fprintf(stderr, "cooperative launch failed: %s (grid %d)\n", hipGetErrorString(e), grid_blocks);
}
```
